# Optimizing an MI355X kernel written in HIP

```python
import jax, jax.numpy as jnp
from jax import lax
import numpy as np

D_MODEL = 1024
BATCH = 1
SEQ = 16384
DEPTH = 1
DEC_BATCH = 16
DEC_SEQ = 2048
PAST_LEN = 128

HEAD_DIM = 64
RWKV_WIDTH = D_MODEL // 2
RWKV_HEADS = RWKV_WIDTH // HEAD_DIM
NA_WIDTH = D_MODEL // 2
NA_HEADS = NA_WIDTH // HEAD_DIM
DECAY_LORA = 64
AAA_LORA = 64
GATE_LORA = 128
GRID_W = 64
NA_ROWS = 8
NA_COLS = 16
D_FF = -(-8 * D_MODEL // (3 * 256)) * 256
PLE_DIM = 256
NORM_EPS = 1e-6
GN_EPS = 64e-5
RWKV_SIZES = (RWKV_WIDTH, RWKV_WIDTH, RWKV_WIDTH, DECAY_LORA, DECAY_LORA, AAA_LORA, AAA_LORA, GATE_LORA)
RWKV_SPLITS = tuple(int(s) for s in np.cumsum(RWKV_SIZES)[:-1])
RWKV_IN = sum(RWKV_SIZES)
NA_IN = 3 * NA_WIDTH
GATE_IN = 2 * D_MODEL
D_IN = RWKV_IN + NA_IN + GATE_IN

kernel_name = 'hybrid_rwkv7_natten_encoder'


def rmsnorm(x, g):
    xf = x.astype(jnp.float32)
    y = xf * lax.rsqrt(jnp.mean(xf * xf, axis=-1, keepdims=True) + NORM_EPS)
    return (y * g.astype(jnp.float32)).astype(x.dtype)


def centred_shift(z, mu_prev, mu_next):
    zp = jnp.pad(z[:, :-1], ((0, 0), (1, 0), (0, 0)))
    zn = jnp.pad(z[:, 1:], ((0, 0), (0, 1), (0, 0)))
    return z + mu_prev * (zp - z) + mu_next * (zn - z)


def wkv7_scan(r, w, k, v, a, b, reverse):
    B, T, H, N = r.shape
    xs = tuple(jnp.moveaxis(t, 1, 0) for t in (r, w, k, v, a, b))

    def step(S, inp):
        r_t, w_t, k_t, v_t, a_t, b_t = inp
        S_new = (S * w_t[:, :, None, :]
                 + jnp.einsum('bhvk,bhk->bhv', S, a_t)[..., None] * b_t[:, :, None, :]
                 + v_t[..., None] * k_t[:, :, None, :])
        y = jnp.einsum('bhvk,bhk->bhv', S if reverse else S_new, r_t)
        return S_new, y

    S0 = jnp.zeros((B, H, N, N), jnp.float32)
    _, ys = lax.scan(step, S0, xs, reverse=reverse)
    return jnp.moveaxis(ys, 0, 1)


def rwkv7_branch(z, L):
    B, T, _ = z.shape
    f32 = jnp.float32
    z = centred_shift(z, L['mu_prev'], L['mu_next'])
    r, k, v, wd_f, wd_b, ad_f, ad_b, gd = jnp.split(z, RWKV_SPLITS, axis=-1)
    r, k, v = r.astype(f32), k.astype(f32), v.astype(f32)

    def decay(wd, w0, w2):
        w = -jax.nn.softplus(-(w0.astype(f32) + (jnp.tanh(wd) @ w2).astype(f32))) - 0.5
        return jnp.exp(-jnp.exp(w))

    def rate(ad, a0, a2):
        return jax.nn.sigmoid(a0.astype(f32) + (ad @ a2).astype(f32))

    w_f = decay(wd_f, L['w0_f'], L['w2_f'])
    w_b = decay(wd_b, L['w0_b'], L['w2_b'])
    a_f = rate(ad_f, L['a0_f'], L['a2_f'])
    a_b = rate(ad_b, L['a0_b'], L['a2_b'])
    g = (jax.nn.sigmoid(gd) @ L['g2']).astype(f32)
    k_a = L['k_a'].astype(f32)
    k_f = k * (1.0 + (a_f - 1.0) * k_a)
    k_b = k * (1.0 + (a_b - 1.0) * k_a)

    hd = lambda t: t.reshape(B, T, RWKV_HEADS, HEAD_DIM)
    kk = hd(k * L['k_k'].astype(f32))
    kk = kk / jnp.maximum(jnp.sqrt(jnp.sum(kk * kk, axis=-1, keepdims=True)), 1e-12)
    rh, vh = hd(r), hd(v)
    o = (wkv7_scan(rh, hd(w_f), hd(k_f), vh, -kk, kk * hd(a_f), False)
         + wkv7_scan(rh, hd(w_b), hd(k_b), vh, -kk, kk * hd(a_b), True))
    mu = jnp.mean(o, axis=-1, keepdims=True)
    var = jnp.mean(jnp.square(o - mu), axis=-1, keepdims=True)
    o = (o - mu) * lax.rsqrt(var + GN_EPS)
    o = o.reshape(B, T, RWKV_WIDTH) * L['lnx_w'].astype(f32) + L['lnx_b'].astype(f32)
    bonus = jnp.sum(rh * hd(0.5 * (k_f + k_b)) * L['r_k'].astype(f32), axis=-1, keepdims=True) * vh
    o = o + bonus.reshape(B, T, RWKV_WIDTH)
    return (o * g).astype(z.dtype)


def neighbourhood_attention(q, k, v, rpb):
    B, T, _ = q.shape
    rows = T // GRID_W
    kh = min(NA_ROWS, rows)
    shp = (B, rows, GRID_W, NA_HEADS, HEAD_DIM)
    q, k, v = q.reshape(shp), k.reshape(shp), v.reshape(shp)
    row_start = jnp.clip(jnp.arange(rows) - kh // 2, 0, rows - kh)
    cols = jnp.arange(GRID_W)
    col_idx = (jnp.clip(cols - NA_COLS // 2, 0, GRID_W - NA_COLS)[:, None]
               + jnp.arange(NA_COLS)[None, :])
    dc_idx = col_idx - cols[:, None] + (NA_COLS - 1)
    col_bias = rpb.astype(jnp.float32)[:, :, dc_idx]
    scale = HEAD_DIM ** -0.5

    def row_block(r):
        rs = row_start[r]
        kr = lax.dynamic_slice_in_dim(k, rs, kh, axis=1)[:, :, col_idx]
        vr = lax.dynamic_slice_in_dim(v, rs, kh, axis=1)[:, :, col_idx]
        qr = lax.dynamic_index_in_dim(q, r, axis=1, keepdims=False)
        s = jnp.einsum('bwhd,biwjhd->bhwij', qr, kr).astype(jnp.float32) * scale
        dr = rs + jnp.arange(kh) - r + (NA_ROWS - 1)
        bias = jnp.take(col_bias, dr, axis=1)
        s = s + jnp.transpose(bias, (0, 2, 1, 3))[None]
        p = jax.nn.softmax(s.reshape(B, NA_HEADS, GRID_W, kh * NA_COLS), axis=-1)
        p = p.reshape(s.shape).astype(v.dtype)
        return jnp.einsum('bhwij,biwjhd->bwhd', p, vr)

    out = lax.map(row_block, jnp.arange(rows))
    return jnp.moveaxis(out, 0, 1).reshape(B, T, NA_WIDTH)


def encoder_layer(x, p, L):
    h = rmsnorm(x, L['g_mix'])
    z = h @ L['w_in']
    z_rwkv = z[..., :RWKV_IN]
    z_na = z[..., RWKV_IN:RWKV_IN + NA_IN]
    z_gate = z[..., RWKV_IN + NA_IN:]
    u_a = rwkv7_branch(z_rwkv, L)
    q, k, v = jnp.split(z_na, 3, axis=-1)
    u_n = neighbourhood_attention(q, k, v, L['rpb'])
    gate_a, gate_n = jnp.split(jax.nn.sigmoid(z_gate), 2, axis=-1)
    m = gate_a * (u_a @ L['w_br_a']) + gate_n * (u_n @ L['w_br_n'])
    x = x + m @ L['w_out']
    h = rmsnorm(x, L['g_ffn'])
    x = x + (jax.nn.silu(h @ L['w_gate']) * (h @ L['w_up'])) @ L['w_down']
    x = x + (p @ L['w_ple']) * jax.nn.sigmoid(rmsnorm(x, L['g_ple']) @ L['w_pg'])
    return x


def trunk(x, p, layers, g_final):
    for i in range(DEPTH):
        L = {name: arr[i] for name, arr in layers.items()}
        x = encoder_layer(x, p[i], L)
    return rmsnorm(x, g_final)


def setup_inputs(seed: int = 0) -> dict:
    key = jax.random.key(seed)
    ks = iter(jax.random.split(key, 40))

    def nrm(shape, scale):
        return scale * jax.random.normal(next(ks), shape, jnp.float32)

    def gain(shape):
        return 1.0 + nrm(shape, 0.02)

    def unif(shape, lo, hi):
        return jax.random.uniform(next(ks), shape, jnp.float32, lo, hi)

    return {
        'x_prompt': nrm((BATCH, SEQ, D_MODEL), 1.0),
        'x_sample': nrm((DEC_BATCH, DEC_SEQ, D_MODEL), 1.0),
        'p_prompt': nrm((DEPTH, BATCH, SEQ, PLE_DIM), 1.0),
        'p_sample': nrm((DEPTH, DEC_BATCH, DEC_SEQ, PLE_DIM), 1.0),
        'g_mix': gain((DEPTH, D_MODEL)),
        'w_in': nrm((DEPTH, D_MODEL, D_IN), D_MODEL ** -0.5),
        'mu_prev': unif((DEPTH, RWKV_IN), 0.0, 0.5),
        'mu_next': unif((DEPTH, RWKV_IN), 0.0, 0.5),
        'w0_f': unif((DEPTH, RWKV_WIDTH), -5.0, -1.0),
        'w2_f': nrm((DEPTH, DECAY_LORA, RWKV_WIDTH), 0.3 * DECAY_LORA ** -0.5),
        'w0_b': unif((DEPTH, RWKV_WIDTH), -5.0, -1.0),
        'w2_b': nrm((DEPTH, DECAY_LORA, RWKV_WIDTH), 0.3 * DECAY_LORA ** -0.5),
        'a0_f': nrm((DEPTH, RWKV_WIDTH), 0.1),
        'a2_f': nrm((DEPTH, AAA_LORA, RWKV_WIDTH), 0.5 * AAA_LORA ** -0.5),
        'a0_b': nrm((DEPTH, RWKV_WIDTH), 0.1),
        'a2_b': nrm((DEPTH, AAA_LORA, RWKV_WIDTH), 0.5 * AAA_LORA ** -0.5),
        'g2': nrm((DEPTH, GATE_LORA, RWKV_WIDTH), GATE_LORA ** -0.5),
        'k_k': 0.85 + nrm((DEPTH, RWKV_WIDTH), 0.02),
        'k_a': gain((DEPTH, RWKV_WIDTH)),
        'r_k': nrm((DEPTH, RWKV_HEADS, HEAD_DIM), 0.1),
        'lnx_w': gain((DEPTH, RWKV_WIDTH)),
        'lnx_b': nrm((DEPTH, RWKV_WIDTH), 0.01),
        'rpb': nrm((DEPTH, NA_HEADS, 2 * NA_ROWS - 1, 2 * NA_COLS - 1), 0.1),
        'w_br_a': nrm((DEPTH, RWKV_WIDTH, D_MODEL), RWKV_WIDTH ** -0.5),
        'w_br_n': nrm((DEPTH, NA_WIDTH, D_MODEL), NA_WIDTH ** -0.5),
        'w_out': nrm((DEPTH, D_MODEL, D_MODEL), D_MODEL ** -0.5),
        'g_ffn': gain((DEPTH, D_MODEL)),
        'w_gate': nrm((DEPTH, D_MODEL, D_FF), D_MODEL ** -0.5),
        'w_up': nrm((DEPTH, D_MODEL, D_FF), D_MODEL ** -0.5),
        'w_down': nrm((DEPTH, D_FF, D_MODEL), D_FF ** -0.5),
        'g_ple': gain((DEPTH, D_MODEL)),
        'w_ple': nrm((DEPTH, PLE_DIM, D_MODEL), PLE_DIM ** -0.5),
        'w_pg': nrm((DEPTH, D_MODEL, D_MODEL), D_MODEL ** -0.5),
        'g_final': gain((D_MODEL,)),
    }


def reference(x_prompt, x_sample, p_prompt, p_sample, g_mix, w_in, mu_prev, mu_next,
              w0_f, w2_f, w0_b, w2_b, a0_f, a2_f, a0_b, a2_b, g2, k_k, k_a, r_k,
              lnx_w, lnx_b, rpb, w_br_a, w_br_n, w_out, g_ffn, w_gate, w_up, w_down,
              g_ple, w_ple, w_pg, g_final):
    layers = {
        'g_mix': g_mix, 'w_in': w_in, 'mu_prev': mu_prev, 'mu_next': mu_next,
        'w0_f': w0_f, 'w2_f': w2_f, 'w0_b': w0_b, 'w2_b': w2_b,
        'a0_f': a0_f, 'a2_f': a2_f, 'a0_b': a0_b, 'a2_b': a2_b,
        'g2': g2, 'k_k': k_k, 'k_a': k_a, 'r_k': r_k, 'lnx_w': lnx_w, 'lnx_b': lnx_b,
        'rpb': rpb, 'w_br_a': w_br_a, 'w_br_n': w_br_n, 'w_out': w_out,
        'g_ffn': g_ffn, 'w_gate': w_gate, 'w_up': w_up, 'w_down': w_down,
        'g_ple': g_ple, 'w_ple': w_ple, 'w_pg': w_pg,
    }
    y_prompt = trunk(x_prompt, p_prompt, layers, g_final)
    y_sample = trunk(x_sample, p_sample, layers, g_final)
    return (y_prompt, y_sample)
```

```cpp
#include <hip/hip_runtime.h>
#include <hip/hip_cooperative_groups.h>
#include <cstdio>
#include <cstdint>
namespace cg = cooperative_groups;

#ifndef SKIP_SCAN
#define SKIP_SCAN 0
#endif
#ifndef SKIP_NA
#define SKIP_NA 0
#endif
#ifndef REP_SCAN
#define REP_SCAN 0
#endif
#ifndef REP_MISC
#define REP_MISC 0
#endif
#ifndef REP_NA
#define REP_NA 0
#endif
#ifndef REP_SYNC
#define REP_SYNC 0
#endif
#ifndef KSTAGGER
#define KSTAGGER 1
#endif
#ifndef REP_GEMM
#define REP_GEMM 0
#endif
#ifndef MK_MULTI
#define MK_MULTI 0
#endif

#define DEV __device__ __forceinline__
#define VT ((int)(threadIdx.x & 255))
#define VB ((int)(blockIdx.x * 2 + (threadIdx.x >> 8)))
#define VG ((int)(gridDim.x * 2))

typedef unsigned short bf16_t;
typedef short bf16x8 __attribute__((ext_vector_type(8)));
typedef short bf16x4 __attribute__((ext_vector_type(4)));
typedef float f32x4 __attribute__((ext_vector_type(4)));
typedef float f32x2 __attribute__((ext_vector_type(2)));
typedef unsigned u32x4 __attribute__((ext_vector_type(4)));
typedef unsigned u32x2 __attribute__((ext_vector_type(2)));

constexpr int NT = 49152, NTP = 16384, DM = 1024, ZW = 3456, DFF = 2816;
constexpr int CH = 256, NCHUNK = NT / CH, NSUB = CH / 16;
constexpr int NPH = 13;

constexpr size_t OFF_WIN_T = 4096;
constexpr size_t OFF_WBRA_T = OFF_WIN_T + (size_t)5504 * 1024 * 2;
constexpr size_t OFF_WBRN_T = OFF_WBRA_T + (size_t)1024 * 512 * 2;
constexpr size_t OFF_WOUT_T = OFF_WBRN_T + (size_t)1024 * 512 * 2;
constexpr size_t OFF_WGATE_T = OFF_WOUT_T + (size_t)1024 * 1024 * 2;
constexpr size_t OFF_WUP_T = OFF_WGATE_T + (size_t)2816 * 1024 * 2;
constexpr size_t OFF_WDOWN_T = OFF_WUP_T + (size_t)2816 * 1024 * 2;
constexpr size_t OFF_WPLE_T = OFF_WDOWN_T + (size_t)2816 * 1024 * 2;
constexpr size_t OFF_WPG_T = OFF_WPLE_T + (size_t)1024 * 256 * 2;
constexpr size_t OFF_HMIX = OFF_WPG_T + (size_t)1024 * 1024 * 2;
constexpr size_t OFF_Z = OFF_HMIX + (size_t)NT * 1024 * 2;
constexpr size_t OFF_UA = OFF_Z + (size_t)NT * ZW * 2;
constexpr size_t OFF_LORA = OFF_UA + (size_t)NT * 512 * 2;
constexpr size_t WS_END1 = OFF_LORA + 196608 * 2;
constexpr size_t OFF_X1 = OFF_HMIX;
constexpr size_t OFF_ACT = OFF_X1 + (size_t)NT * 1024 * 4;
constexpr size_t WS_END2 = OFF_ACT + (size_t)NT * DFF * 2;
static_assert(WS_END1 <= 536870912ull && WS_END2 <= 536870912ull, "workspace");
constexpr size_t OUT_PBF = (size_t)NT * 1024 * 2;

constexpr int LDS_BYTES = 131072;

struct Params {
    const float* in[34];
    float* out;
    unsigned char* ws;
    int ph_lo, ph_hi;
};

typedef __bf16 bf16x2n __attribute__((ext_vector_type(2)));
DEV unsigned pk2(float lo, float hi) { const f32x2 v = {lo, hi}; return __builtin_bit_cast(unsigned, __builtin_convertvector(v, bf16x2n)); }
DEV float bf_lo(unsigned u) { return __uint_as_float(u << 16); }
DEV float bf_hi(unsigned u) { return __uint_as_float(u & 0xffff0000u); }
DEV f32x4 ld4bf(const bf16_t* p) { u32x2 u = *(const u32x2*)p; return (f32x4){bf_lo(u.x), bf_hi(u.x), bf_lo(u.y), bf_hi(u.y)}; }
DEV void st4bf(bf16_t* p, f32x4 v) { u32x2 u; u.x = pk2(v[0], v[1]); u.y = pk2(v[2], v[3]); *(u32x2*)p = u; }
DEV float wave_sum(float v) {
#pragma unroll
    for (int o = 32; o > 0; o >>= 1) v += __shfl_xor(v, o);
    return v;
}
DEV float dpp_x1(float v) { return __int_as_float(__builtin_amdgcn_update_dpp(0, __float_as_int(v), 0xB1, 0xF, 0xF, true)); }
DEV float dpp_x2(float v) { return __int_as_float(__builtin_amdgcn_update_dpp(0, __float_as_int(v), 0x4E, 0xF, 0xF, true)); }
DEV float dpp_hm(float v) { return __int_as_float(__builtin_amdgcn_update_dpp(0, __float_as_int(v), 0x141, 0xF, 0xF, true)); }
DEV float dpp_rm(float v) { return __int_as_float(__builtin_amdgcn_update_dpp(0, __float_as_int(v), 0x140, 0xF, 0xF, true)); }
DEV float sum16(float v) { v += dpp_x1(v); v += dpp_x2(v); v += dpp_hm(v); v += dpp_rm(v); return v; }
DEV float sigmoidf_(float x) { return __builtin_amdgcn_rcpf(1.f + __expf(-x)); }
DEV const float* xrow(const Params& p, int t) { return t < NTP ? p.in[0] + (size_t)t * DM : p.in[1] + (size_t)(t - NTP) * DM; }
DEV const float* prow(const Params& p, int t) { return t < NTP ? p.in[2] + (size_t)t * 256 : p.in[3] + (size_t)(t - NTP) * 256; }

template <int rmode = 0>
DEV void transpose_tile(const float* __restrict__ W, int K, int N, bf16_t* __restrict__ Wt, int tile, float* lds) {
    const int ntn = N / 64, kb = tile / ntn, nb = tile % ntn, k0 = kb * 64, n0 = nb * 64, tid = VT;
#pragma unroll
    for (int i = 0; i < 16; ++i) { const int kk = (tid >> 6) + 4 * i; lds[kk * 65 + (tid & 63)] = W[(size_t)(k0 + kk) * N + n0 + (tid & 63)]; }
    __syncthreads();
    const int n = tid >> 2, kq = tid & 3;
    unsigned w[8];
#pragma unroll
    for (int j = 0; j < 8; ++j) w[j] = pk2(lds[(kq * 16 + 2 * j) * 65 + n], lds[(kq * 16 + 2 * j + 1) * 65 + n]);
    const int nsrc = n0 + n, nrow = rmode == 0 ? nsrc : ((nsrc >> 4) * 32 + (nsrc & 15) + (rmode == 2 ? 16 : 0));
    u32x4* dst = (u32x4*)(Wt + (size_t)nrow * K + k0 + kq * 16);
    dst[0] = (u32x4){w[0], w[1], w[2], w[3]};
    dst[1] = (u32x4){w[4], w[5], w[6], w[7]};
    __syncthreads();
}

DEV void norm_row_bf16(const float* __restrict__ src, const float* __restrict__ g, bf16_t* __restrict__ dst, int lane) {
    f32x4 v[4]; float s = 0.f;
#pragma unroll
    for (int j = 0; j < 4; ++j) { v[j] = *(const f32x4*)(src + j * 256 + lane * 4); s += v[j][0] * v[j][0] + v[j][1] * v[j][1] + v[j][2] * v[j][2] + v[j][3] * v[j][3]; }
    s = wave_sum(s);
    const float r = 1.0f / sqrtf(s * (1.f / 1024.f) + 1e-6f);
#pragma unroll
    for (int j = 0; j < 4; ++j) { const f32x4 gg = *(const f32x4*)(g + j * 256 + lane * 4); st4bf(dst + j * 256 + lane * 4, v[j] * r * gg); }
}
DEV void norm_row_f32(const float* __restrict__ src, const float* __restrict__ g, float* __restrict__ dst, int lane) {
    f32x4 v[4]; float s = 0.f;
#pragma unroll
    for (int j = 0; j < 4; ++j) { v[j] = *(const f32x4*)(src + j * 256 + lane * 4); s += v[j][0] * v[j][0] + v[j][1] * v[j][1] + v[j][2] * v[j][2] + v[j][3] * v[j][3]; }
    s = wave_sum(s);
    const float r = 1.0f / sqrtf(s * (1.f / 1024.f) + 1e-6f);
#pragma unroll
    for (int j = 0; j < 4; ++j) { const f32x4 gg = *(const f32x4*)(g + j * 256 + lane * 4); *(f32x4*)(dst + j * 256 + lane * 4) = v[j] * r * gg; }
}

DEV void phase0(const Params& p, unsigned char* ldsb) {
    float* lds = (float*)ldsb;
    constexpr int T0 = 16 * 86, T1 = 8 * 16, T2 = 8 * 16, T3 = 16 * 16, T4 = 16 * 44, T5 = 16 * 44, T6 = 44 * 16, T7 = 4 * 16, T8 = 16 * 16;
    constexpr int NTILES = T0 + T1 + T2 + T3 + T4 + T5 + T6 + T7 + T8 + 48;
    for (int it = VB; it < NTILES; it += VG) {
        int r = it;
        if (r < T0) { transpose_tile(p.in[5], 1024, 5504, (bf16_t*)(p.ws + OFF_WIN_T), r, lds); continue; } r -= T0;
        if (r < T1) { transpose_tile(p.in[23], 512, 1024, (bf16_t*)(p.ws + OFF_WBRA_T), r, lds); continue; } r -= T1;
        if (r < T2) { transpose_tile(p.in[24], 512, 1024, (bf16_t*)(p.ws + OFF_WBRN_T), r, lds); continue; } r -= T2;
        if (r < T3) { transpose_tile(p.in[25], 1024, 1024, (bf16_t*)(p.ws + OFF_WOUT_T), r, lds); continue; } r -= T3;
        if (r < T4) { transpose_tile<1>(p.in[27], 1024, 2816, (bf16_t*)(p.ws + OFF_WGATE_T), r, lds); continue; } r -= T4;
        if (r < T5) { transpose_tile<2>(p.in[28], 1024, 2816, (bf16_t*)(p.ws + OFF_WGATE_T), r, lds); continue; } r -= T5;
        if (r < T6) { transpose_tile(p.in[29], 2816, 1024, (bf16_t*)(p.ws + OFF_WDOWN_T), r, lds); continue; } r -= T6;
        if (r < T7) { transpose_tile(p.in[31], 256, 1024, (bf16_t*)(p.ws + OFF_WPLE_T), r, lds); continue; } r -= T7;
        if (r < T8) { transpose_tile(p.in[32], 1024, 1024, (bf16_t*)(p.ws + OFF_WPG_T), r, lds); continue; } r -= T8;
        bf16_t* lb = (bf16_t*)(p.ws + OFF_LORA);
        if (r < 8) { transpose_tile(p.in[9], 64, 512, lb, r, lds); continue; } r -= 8;
        if (r < 8) { transpose_tile(p.in[11], 64, 512, lb + 32768, r, lds); continue; } r -= 8;
        if (r < 8) { transpose_tile(p.in[13], 64, 512, lb + 65536, r, lds); continue; } r -= 8;
        if (r < 8) { transpose_tile(p.in[15], 64, 512, lb + 98304, r, lds); continue; } r -= 8;
        transpose_tile(p.in[16], 128, 512, lb + 131072, r, lds);
    }
    const int wave = VT >> 6, lane = VT & 63;
    bf16_t* hmix = (bf16_t*)(p.ws + OFF_HMIX);
    for (int t = VB * 4 + wave; t < NT; t += VG * 4) norm_row_bf16(xrow(p, t), p.in[4], hmix + (size_t)t * DM, lane);
}

DEV void gemm_acc(f32x4 (&acc)[4][4], const bf16_t* __restrict__ A, int lda, const bf16_t* __restrict__ Bt, int ldb, int K, unsigned char* lds) {
    const int tid = VT, wid = tid >> 6, lane = tid & 63, wr = wid >> 1, wc = wid & 1, fr = lane & 15, fq = lane >> 4;
    const int lr = tid >> 3, lc = tid & 7;
    const bf16_t* ga = A + (size_t)lr * lda + lc * 8;
    const bf16_t* gb = Bt + (size_t)lr * ldb + lc * 8;
    const size_t sa32 = (size_t)32 * lda, sb32 = (size_t)32 * ldb;
    const int soff = lr * 128 + ((lc ^ (lr & 7)) << 4);
    u32x4 ra[4], rb[4];
    const int nk = K >> 6;
#pragma unroll
    for (int i = 0; i < 4; ++i) { ra[i] = *(const u32x4*)(ga + i * sa32); rb[i] = *(const u32x4*)(gb + i * sb32); }
#pragma unroll
    for (int i = 0; i < 4; ++i) { *(u32x4*)(lds + soff + i * 4096) = ra[i]; *(u32x4*)(lds + 16384 + soff + i * 4096) = rb[i]; }
    __syncthreads();
#pragma unroll 1
    for (int kt = 0; kt < nk; ++kt) {
        const bool more = (kt + 1) < nk;
        if (more) {
#pragma unroll
            for (int i = 0; i < 4; ++i) { ra[i] = *(const u32x4*)(ga + i * sa32 + (kt + 1) * 64); rb[i] = *(const u32x4*)(gb + i * sb32 + (kt + 1) * 64); }
        }
        const unsigned char* sa = lds + (kt & 1) * 32768;
        const unsigned char* sb = sa + 16384;
#pragma unroll
        for (int ks = 0; ks < 2; ++ks) {
            bf16x8 af[4], bfr[4];
            const int ch = ((ks * 4 + fq) ^ (fr & 7)) << 4;
#pragma unroll
            for (int m = 0; m < 4; ++m) af[m] = *(const bf16x8*)(sa + (wr * 64 + m * 16 + fr) * 128 + ch);
#pragma unroll
            for (int n = 0; n < 4; ++n) bfr[n] = *(const bf16x8*)(sb + (wc * 64 + n * 16 + fr) * 128 + ch);
#pragma unroll
            for (int m = 0; m < 4; ++m)
#pragma unroll
                for (int n = 0; n < 4; ++n) acc[m][n] = __builtin_amdgcn_mfma_f32_16x16x32_bf16(bfr[n], af[m], acc[m][n], 0, 0, 0);
        }
        if (more) {
            unsigned char* d = lds + ((kt + 1) & 1) * 32768;
#pragma unroll
            for (int i = 0; i < 4; ++i) { *(u32x4*)(d + soff + i * 4096) = ra[i]; *(u32x4*)(d + 16384 + soff + i * 4096) = rb[i]; }
        }
        __syncthreads();
    }
}
DEV void zero_acc(f32x4 (&acc)[4][4]) {
#pragma unroll
    for (int m = 0; m < 4; ++m)
#pragma unroll
        for (int n = 0; n < 4; ++n) acc[m][n] = (f32x4){0.f, 0.f, 0.f, 0.f};
}

struct TileIter {
    int ntn, per_xcd, i, step, x, rows_x;
    DEV void init(int ntm, int ntn_) {
        ntn = ntn_;
        if ((gridDim.x & 7) == 0 && (ntm & 63) == 0) { x = blockIdx.x & 7; i = (int)(blockIdx.x >> 3) * 2 + (int)(threadIdx.x >> 8); step = (int)(gridDim.x >> 3) * 2; rows_x = ntm >> 3; per_xcd = rows_x * ntn; }
        else { x = -1; i = VB; step = VG; rows_x = ntm; per_xcd = ntm * ntn; }
    }
    DEV bool next(int& tm, int& tn) {
        if (i >= per_xcd) return false;
        if (x >= 0) { const int g = i / (8 * ntn), rem = i - g * 8 * ntn; tn = rem >> 3; tm = x * rows_x + g * 8 + (rem & 7); }
        else { tm = i / ntn; tn = i - tm * ntn; }
        i += step; return true;
    }
};

DEV void gemm256_acc(f32x4 (&acc)[8][4], const bf16_t* __restrict__ A, int lda, const bf16_t* __restrict__ Bt, int ldb, int K, unsigned char* lds) {
    __builtin_amdgcn_sched_barrier(0);
    const int tid = threadIdx.x, wid = tid >> 6, lane = tid & 63, wr = wid >> 2, wc = wid & 3, fr = lane & 15, fq = lane >> 4;
    int ozg; asm volatile("s_mov_b32 %0, 0" : "=s"(ozg));
    const int drow = (lane >> 3) + ozg, dch = (lane & 7) ^ (lane >> 3);
    const bf16_t* ga = A + (size_t)(wid * 32 + drow) * lda + dch * 8;
    const bf16_t* gb = Bt + (size_t)(wid * 32 + drow) * ldb + dch * 8;
    const size_t a8 = (size_t)8 * lda, b8 = (size_t)8 * ldb;
    const int nk = K >> 6;
    int kbase = (int)(KSTAGGER == 1 ? (blockIdx.x & 7) * nk / 8 : (KSTAGGER == 2 ? ((blockIdx.x >> 6) & 3) * nk / 4 : 0));
    asm volatile("s_waitcnt vmcnt(0)" ::: "memory");
#define G256_STAGE(kt_) do { unsigned char* sd_ = lds + ((kt_) & 1) * 65536 + wid * 4096; int kk_ = (kt_) + kbase; if (kk_ >= nk) kk_ -= nk; const int ko_ = kk_ * 64; \
        _Pragma("unroll") for (int i_ = 0; i_ < 4; ++i_) { \
            __builtin_amdgcn_global_load_lds((const unsigned*)(ga + i_ * a8 + ko_), (unsigned*)(sd_ + i_ * 1024), 16, 0, 0); \
            __builtin_amdgcn_global_load_lds((const unsigned*)(gb + i_ * b8 + ko_), (unsigned*)(sd_ + 32768 + i_ * 1024), 16, 0, 0); } } while (0)
    const int ch0 = (fq ^ (fr & 7)) << 4, ch1 = ((4 + fq) ^ (fr & 7)) << 4;
    const int aoff = (wr * 128 + fr) * 128, boff = 32768 + (wc * 64 + fr) * 128;
    bf16x8 bf0[4], bf1[4], afA[4], afB[4];
#define LD_B(dst, ch) _Pragma("unroll") for (int n = 0; n < 4; ++n) dst[n] = *(const bf16x8*)(sb + n * 2048 + (ch))
#define LD_A(dst, mh, ch) _Pragma("unroll") for (int m = 0; m < 4; ++m) dst[m] = *(const bf16x8*)(sa + ((mh) * 4 + m) * 2048 + (ch))
#define MM(af, bf, mh) _Pragma("unroll") for (int m = 0; m < 4; ++m) _Pragma("unroll") for (int n = 0; n < 4; ++n) \
            acc[(mh) * 4 + m][n] = __builtin_amdgcn_mfma_f32_16x16x32_bf16(bf[n], af[m], acc[(mh) * 4 + m][n], 0, 0, 0)
#define SB_ __builtin_amdgcn_sched_barrier(0)
    G256_STAGE(0);
    asm volatile("s_waitcnt vmcnt(0)" ::: "memory");
    __builtin_amdgcn_s_barrier();
    if (nk > 1) G256_STAGE(1);
    {
        const unsigned char* sa = lds + aoff; const unsigned char* sb = lds + boff;
        LD_B(bf0, ch0); LD_A(afA, 0, ch0); SB_;
    }
#pragma unroll 1
    for (int kt = 0; kt < nk; ++kt) {
        const unsigned char* sa = lds + (kt & 1) * 65536 + aoff;
        const unsigned char* sb = lds + (kt & 1) * 65536 + boff;
        LD_A(afB, 1, ch0); SB_;
        MM(afA, bf0, 0); SB_;
        LD_B(bf1, ch1); LD_A(afA, 0, ch1); SB_;
        MM(afB, bf0, 1); SB_;
        LD_A(afB, 1, ch1); SB_;
        MM(afA, bf1, 0); SB_;
        asm volatile("s_waitcnt lgkmcnt(0)" ::: "memory");
        asm volatile("s_waitcnt vmcnt(0)" ::: "memory");
        __builtin_amdgcn_s_barrier();
        SB_;
        if (kt + 2 < nk) G256_STAGE(kt + 2);
        if (kt + 1 < nk) {
            const unsigned char* sa = lds + ((kt + 1) & 1) * 65536 + aoff;
            const unsigned char* sb = lds + ((kt + 1) & 1) * 65536 + boff;
            LD_B(bf0, ch0); LD_A(afA, 0, ch0);
        }
        SB_;
        MM(afB, bf1, 1); SB_;
    }
#undef SB_
#undef LD_B
#undef LD_A
#undef MM
#undef G256_STAGE
}
DEV void zero_acc256(f32x4 (&acc)[8][4]) {
#pragma unroll
    for (int m = 0; m < 8; ++m)
#pragma unroll
        for (int n = 0; n < 4; ++n) acc[m][n] = (f32x4){0.f, 0.f, 0.f, 0.f};
}
struct TileIter256 {
    int ntn, per_xcd, i, step, x, rows_x;
    DEV void init(int ntm, int ntn_) {
        ntn = ntn_;
        if ((gridDim.x & 7) == 0 && (ntm & 63) == 0) { x = blockIdx.x & 7; i = blockIdx.x >> 3; step = gridDim.x >> 3; rows_x = ntm >> 3; per_xcd = rows_x * ntn; }
        else { x = -1; i = blockIdx.x; step = gridDim.x; rows_x = ntm; per_xcd = ntm * ntn; }
    }
    DEV bool next(int& tm, int& tn) {
        if (i >= per_xcd) return false;
        if (x >= 0) { const int g = i / (8 * ntn), rem = i - g * 8 * ntn; tn = rem >> 3; tm = x * rows_x + g * 8 + (rem & 7); }
        else { tm = i / ntn; tn = i - tm * ntn; }
        i += step; return true;
    }
};
#define EPI256_COORDS const int tid_ = threadIdx.x, wid_ = tid_ >> 6, lane_ = tid_ & 63, wr_ = wid_ >> 2, wc_ = wid_ & 3, fr_ = lane_ & 15, fq_ = lane_ >> 4;
#define EPI256_ROW(m) (row0 + wr_ * 128 + (m) * 16 + fr_)
#define EPI256_COL(n) (col0 + wc_ * 64 + (n) * 16 + fq_ * 4)

#define EPI_COORDS const int tid_ = VT, wid_ = tid_ >> 6, lane_ = tid_ & 63, wr_ = wid_ >> 1, wc_ = wid_ & 1, fr_ = lane_ & 15, fq_ = lane_ >> 4;
#define EPI_ROW(m) (row0 + wr_ * 64 + (m) * 16 + fr_)
#define EPI_COL(n) (col0 + wc_ * 64 + (n) * 16 + fq_ * 4)

DEV void phase1(const Params& p, unsigned char* lds_all) {
    const bf16_t* hmix = (const bf16_t*)(p.ws + OFF_HMIX);
    const bf16_t* wt = (const bf16_t*)(p.ws + OFF_WIN_T);
    bf16_t* z = (bf16_t*)(p.ws + OFF_Z);
    constexpr int NTN = (ZW + 255) / 256;
    TileIter256 ti; ti.init(NT / 256, NTN);
    for (int tm_, tn_; ti.next(tm_, tn_);) {
        const int row0 = tm_ * 256, col0 = tn_ * 256;
        f32x4 acc[8][4]; zero_acc256(acc);
        gemm256_acc(acc, hmix + (size_t)row0 * DM, DM, wt + (size_t)col0 * DM, DM, DM, lds_all);
        EPI256_COORDS
        int oz; asm volatile("s_mov_b32 %0, 0" : "=s"(oz));
#pragma unroll
        for (int m = 0; m < 8; ++m)
#pragma unroll
            for (int n = 0; n < 4; ++n) {
                const int rl = wr_ * 128 + m * 16 + fr_ + oz, cl = wc_ * 64 + n * 16 + fq_ * 4;
                u32x2 u; u.x = pk2(acc[m][n][0], acc[m][n][1]); u.y = pk2(acc[m][n][2], acc[m][n][3]);
                *(u32x2*)(lds_all + rl * 512 + (((cl >> 3) ^ (rl & 31)) << 4) + ((cl & 7) << 1)) = u;
            }
        __syncthreads();
#pragma unroll
        for (int k = 0; k < 16; ++k) {
            const int idx = tid_ + 512 * k + oz, rl = idx >> 5, ch = idx & 31;
            const u32x4 v = *(const u32x4*)(lds_all + rl * 512 + ((ch ^ (rl & 31)) << 4));
            const int col = col0 + ch * 8;
            if (col < ZW) *(u32x4*)(z + (size_t)(row0 + rl) * ZW + col) = v;
        }
        __syncthreads();
    }
}

constexpr int L_WD = 0, L_AA = 1024, L_BD = 2048, L_KD = 3072, L_RR = 4096, L_VV = 5120, L_XW = 6144, L_XA = 7168, L_BDOT = 8192  , L_O = 10368, L_LG = 11392;
constexpr int LB_XWB = 49664, LB_XAB = 51968, LB_XGB = 54272;

DEV f32x4 shift4(const bf16_t* __restrict__ z, int t, int col, int sstart, int send, const float* __restrict__ mup, const float* __restrict__ mun) {
    const bf16_t* q = z + (size_t)t * ZW + col;
    const f32x4 c = ld4bf(q);
    f32x4 zp = (f32x4){0.f, 0.f, 0.f, 0.f}, zn = (f32x4){0.f, 0.f, 0.f, 0.f};
    if (t > sstart) zp = ld4bf(q - ZW);
    if (t < send - 1) zn = ld4bf(q + ZW);
    const f32x4 mp = *(const f32x4*)(mup + col), mn = *(const f32x4*)(mun + col);
    return c + mp * (zp - c) + mn * (zn - c);
}

struct Raw3 { u32x2 c, p, n; };
DEV Raw3 shift_load(const bf16_t* __restrict__ z, int t, int col, int sstart, int send) {
    const bf16_t* q = z + (size_t)t * ZW + col;
    Raw3 r; r.c = *(const u32x2*)q; r.p = (u32x2){0u, 0u}; r.n = (u32x2){0u, 0u};
    if (t > sstart) r.p = *(const u32x2*)(q - ZW);
    if (t < send - 1) r.n = *(const u32x2*)(q + ZW);
    return r;
}
DEV f32x4 shift_apply(const Raw3& r, int col, const float* __restrict__ mup, const float* __restrict__ mun) {
    const f32x4 c = (f32x4){bf_lo(r.c.x), bf_hi(r.c.x), bf_lo(r.c.y), bf_hi(r.c.y)};
    const f32x4 zp = (f32x4){bf_lo(r.p.x), bf_hi(r.p.x), bf_lo(r.p.y), bf_hi(r.p.y)};
    const f32x4 zn = (f32x4){bf_lo(r.n.x), bf_hi(r.n.x), bf_lo(r.n.y), bf_hi(r.n.y)};
    const f32x4 mp = *(const f32x4*)(mup + col), mn = *(const f32x4*)(mun + col);
    return c + mp * (zp - c) + mn * (zn - c);
}

struct LoraFrag { bf16x8 w[2], a[2], g[4]; };
template <bool L3, int d>
DEV void lora_load(const Params& p, LoraFrag& lf, int h) {
    const int lane = VT & 63, w = VT >> 6, fr = lane & 15, fq = lane >> 4;
    const int c = h * 64 + w * 16 + fr;
    const bf16_t* base = (const bf16_t*)(p.ws + OFF_LORA);
    const bf16_t* w2t = base + (d ? 32768 : 0) + c * 64 + fq * 8;
    const bf16_t* a2t = base + 65536 + (d ? 32768 : 0) + c * 64 + fq * 8;
#pragma unroll
    for (int ks = 0; ks < 2; ++ks) { lf.w[ks] = *(const bf16x8*)(w2t + ks * 32); lf.a[ks] = *(const bf16x8*)(a2t + ks * 32); }
    if (L3 && d == 1) {
        const bf16_t* g2t = base + 131072 + c * 128 + fq * 8;
#pragma unroll
        for (int ks = 0; ks < 4; ++ks) lf.g[ks] = *(const bf16x8*)(g2t + ks * 32);
    }
}
DEV float tanh_fast(float x) { return 1.f - 2.f * __builtin_amdgcn_rcpf(1.f + __expf(2.f * x)); }

template <bool L3, int d>
DEV void scan_prep(const Params& p, float* lds, const LoraFrag& lf, int ts, int tloc0, int h, int sstart, int send) {
    const bf16_t* z = (const bf16_t*)(p.ws + OFF_Z);
    const float* mup = p.in[6];
    const float* mun = p.in[7];
    const int tid = VT, tt = tid >> 4, q16 = tid & 15, t = ts + tt;
    const int j0 = q16 * 4, c0 = h * 64 + j0;
    bf16_t* xwb = (bf16_t*)((unsigned char*)lds + LB_XWB);
    bf16_t* xab = (bf16_t*)((unsigned char*)lds + LB_XAB);
    bf16_t* xgb = (bf16_t*)((unsigned char*)lds + LB_XGB);
    const f32x4 xw = shift4(z, t, 1536 + d * 64 + j0, sstart, send, mup, mun);
    const f32x4 xa = shift4(z, t, 1664 + d * 64 + j0, sstart, send, mup, mun);
    const Raw3 rr = shift_load(z, t, c0, sstart, send), rk3 = shift_load(z, t, 512 + c0, sstart, send), rv = shift_load(z, t, 1024 + c0, sstart, send);
    st4bf(xwb + tt * 72 + j0, (f32x4){tanh_fast(xw[0]), tanh_fast(xw[1]), tanh_fast(xw[2]), tanh_fast(xw[3])});
    st4bf(xab + tt * 72 + j0, xa);
    if (L3 && d == 1) {
#pragma unroll
        for (int e = 0; e < 2; ++e) {
            const f32x4 xg = shift4(z, t, 1792 + q16 * 8 + e * 4, sstart, send, mup, mun);
            st4bf(xgb + tt * 136 + q16 * 8 + e * 4, (f32x4){sigmoidf_(xg[0]), sigmoidf_(xg[1]), sigmoidf_(xg[2]), sigmoidf_(xg[3])});
        }
    }
    __syncthreads();
    {
        const int lane = tid & 63, w = tid >> 6, fr = lane & 15, fq = lane >> 4;
        f32x4 cw = (f32x4){0.f, 0.f, 0.f, 0.f}, ca = cw;
#pragma unroll
        for (int ks = 0; ks < 2; ++ks) {
            const bf16x8 aw = *(const bf16x8*)(xwb + fr * 72 + ks * 32 + fq * 8);
            const bf16x8 aa = *(const bf16x8*)(xab + fr * 72 + ks * 32 + fq * 8);
            cw = __builtin_amdgcn_mfma_f32_16x16x32_bf16(aw, lf.w[ks], cw, 0, 0, 0);
            ca = __builtin_amdgcn_mfma_f32_16x16x32_bf16(aa, lf.a[ks], ca, 0, 0, 0);
        }
#pragma unroll
        for (int j = 0; j < 4; ++j) { lds[L_XW + (fq * 4 + j) * 64 + w * 16 + fr] = cw[j]; lds[L_XA + (fq * 4 + j) * 64 + w * 16 + fr] = ca[j]; }
        if (L3 && d == 1) {
            f32x4 cg = (f32x4){0.f, 0.f, 0.f, 0.f};
#pragma unroll
            for (int ks = 0; ks < 4; ++ks) {
                const bf16x8 ag = *(const bf16x8*)(xgb + fr * 136 + ks * 32 + fq * 8);
                cg = __builtin_amdgcn_mfma_f32_16x16x32_bf16(ag, lf.g[ks], cg, 0, 0, 0);
            }
#pragma unroll
            for (int j = 0; j < 4; ++j) lds[L_LG + (fq * 4 + j) * 64 + w * 16 + fr] = cg[j];
        }
    }
    __syncthreads();
    const f32x4 r4 = shift_apply(rr, c0, mup, mun), k4 = shift_apply(rk3, 512 + c0, mup, mun), v4 = shift_apply(rv, 1024 + c0, mup, mun);
    const f32x4 lw = *(const f32x4*)(lds + L_XW + tt * 64 + j0), la = *(const f32x4*)(lds + L_XA + tt * 64 + j0);
    const f32x4 w0 = *(const f32x4*)((d ? p.in[10] : p.in[8]) + c0);
    const f32x4 a0 = *(const f32x4*)((d ? p.in[14] : p.in[12]) + c0);
    const f32x4 kkw = *(const f32x4*)(p.in[17] + c0);
    const f32x4 kaw = *(const f32x4*)(p.in[18] + c0);
    f32x4 wd, ar, kk;
    float ss = 0.f;
#pragma unroll
    for (int j = 0; j < 4; ++j) {
        const float x = w0[j] + lw[j];
        const float sp = fmaxf(-x, 0.f) + __logf(1.f + __expf(-fabsf(x)));
        wd[j] = __expf(-__expf(-sp - 0.5f));
        ar[j] = __builtin_amdgcn_rcpf(1.f + __expf(-(a0[j] + la[j])));
        kk[j] = k4[j] * kkw[j];
        ss += kk[j] * kk[j];
    }
    ss = sum16(ss);
    const float inv = 1.f / fmaxf(sqrtf(ss), 1e-12f);
    kk = kk * inv;
    f32x4 kd;
#pragma unroll
    for (int j = 0; j < 4; ++j) kd[j] = k4[j] * (1.f + (ar[j] - 1.f) * kaw[j]);
    *(f32x4*)(lds + L_WD + tt * 64 + j0) = wd;
    *(f32x4*)(lds + L_AA + tt * 64 + j0) = -kk;
    *(f32x4*)(lds + L_BD + tt * 64 + j0) = kk * ar;
    *(f32x4*)(lds + L_KD + tt * 64 + j0) = kd;
    *(f32x4*)(lds + L_RR + tt * 64 + j0) = r4;
    *(f32x4*)(lds + L_VV + tt * 64 + j0) = v4;
    if (L3) {
        const f32x4 rk = *(const f32x4*)(p.in[19] + c0);
        float bd = r4[0] * kd[0] * rk[0] + r4[1] * kd[1] * rk[1] + r4[2] * kd[2] * rk[2] + r4[3] * kd[3] * rk[3];
        bd = sum16(bd);
        if (q16 == 0) lds[L_BDOT + tloc0 + tt] += 0.5f * bd;
    }
    __syncthreads();
}

DEV unsigned prefetch_touch(const bf16_t* z, int ts_next, int h, int d, int sstart, int send) {
    unsigned dummy = 0u;
    const int tid = VT;
    if (tid < 126) {
        const int ti = tid / 7, j = tid - ti * 7;
        int t = ts_next - 1 + ti; t = t < sstart ? sstart : t; t = t > send - 1 ? send - 1 : t;
        const int col = j < 3 ? j * 512 + h * 64 : (j == 3 ? 1536 + d * 64 : (j == 4 ? 1664 + d * 64 : (j == 5 ? 1792 : 1856)));
        const bf16_t* q = z + (size_t)t * ZW + col;
        asm volatile("global_load_dword %0, %1, off" : "=v"(dummy) : "v"(q) : "memory");
    }
    return dummy;
}
DEV void prefetch_retire(unsigned dummy) {
    asm volatile("s_waitcnt vmcnt(0)" ::: "memory");
    asm volatile("" :: "v"(dummy));
}

DEV void seq_bounds(int t0, int& sstart, int& send) {
    if (t0 < NTP) { sstart = 0; send = NTP; }
    else { sstart = NTP + ((t0 - NTP) >> 11) * 2048; send = sstart + 2048; }
}

template <int d>
DEV void l1_body(const Params& p, int item, unsigned char* ldsb) {
    float* lds = (float*)ldsb;
    const int h = item & 7, c = item >> 4, t0 = c * CH;
    int sstart, send; seq_bounds(t0, sstart, send);
    const int tid = VT, rp = tid >> 2, part = tid & 3, cb = part * 16;
    f32x2 Sp[8], Su[8];
    int opq; asm volatile("s_mov_b32 %0, 0" : "=s"(opq));
#pragma unroll
    for (int j = 0; j < 8; ++j) { Sp[j] = (f32x2){(rp + opq == cb + 2 * j) ? 1.f : 0.f, (rp + opq == cb + 2 * j + 1) ? 1.f : 0.f}; Su[j] = (f32x2){0.f, 0.f}; }
    LoraFrag lf; lora_load<false, d>(p, lf, h);
    for (int sci = 0; sci < NSUB; ++sci) {
        const int sc = d ? NSUB - 1 - sci : sci;
        scan_prep<false, d>(p, lds, lf, t0 + sc * 16, sc * 16, h, sstart, send);
        const unsigned pfd = prefetch_touch((const bf16_t*)(p.ws + OFF_Z), t0 + (sci + 1 < NSUB ? (d ? sc - 1 : sc + 1) : sc) * 16, h, d, sstart, send);
        f32x4 an[4]; float vvn;
        {
            const int tf = d ? 15 : 0;
#pragma unroll
            for (int j4 = 0; j4 < 4; ++j4) an[j4] = *(const f32x4*)(lds + L_AA + tf * 64 + cb + j4 * 4);
            vvn = lds[L_VV + tf * 64 + rp];
        }
#pragma unroll 1
        for (int sti = 0; sti < 16; ++sti) {
            const int tl = d ? 15 - sti : sti;
            const int tnx = sti == 15 ? tl : (d ? tl - 1 : tl + 1);
            const float* wp = lds + L_WD + tl * 64 + cb;
            const float* bp = lds + L_BD + tl * 64 + cb;
            const float* kp = lds + L_KD + tl * 64 + cb;
            const float vv = vvn;
            f32x4 ac[4];
#pragma unroll
            for (int j4 = 0; j4 < 4; ++j4) ac[j4] = an[j4];
#pragma unroll
            for (int j4 = 0; j4 < 4; ++j4) an[j4] = *(const f32x4*)(lds + L_AA + tnx * 64 + cb + j4 * 4);
            vvn = lds[L_VV + tnx * 64 + rp];
            f32x2 dp = (f32x2){0.f, 0.f}, du = dp;
#pragma unroll
            for (int j4 = 0; j4 < 4; ++j4) {
                const f32x4 a = ac[j4];
                const f32x2 a0 = (f32x2){a[0], a[1]}, a1 = (f32x2){a[2], a[3]};
                dp += Sp[2 * j4] * a0; du += Su[2 * j4] * a0;
                dp += Sp[2 * j4 + 1] * a1; du += Su[2 * j4 + 1] * a1;
            }
            float sap = dp[0] + dp[1], sau = du[0] + du[1];
            sap += dpp_x1(sap); sau += dpp_x1(sau);
            sap += dpp_x2(sap); sau += dpp_x2(sau);
#pragma unroll
            for (int j4 = 0; j4 < 4; ++j4) {
                const f32x4 w = *(const f32x4*)(wp + j4 * 4), b = *(const f32x4*)(bp + j4 * 4), k = *(const f32x4*)(kp + j4 * 4);
                const f32x2 w0 = (f32x2){w[0], w[1]}, w1 = (f32x2){w[2], w[3]}, b0 = (f32x2){b[0], b[1]}, b1 = (f32x2){b[2], b[3]}, k0 = (f32x2){k[0], k[1]}, k1 = (f32x2){k[2], k[3]};
                Sp[2 * j4] = Sp[2 * j4] * w0 + sap * b0;
                Sp[2 * j4 + 1] = Sp[2 * j4 + 1] * w1 + sap * b1;
                Su[2 * j4] = Su[2 * j4] * w0 + (sau * b0 + vv * k0);
                Su[2 * j4 + 1] = Su[2 * j4 + 1] * w1 + (sau * b1 + vv * k1);
            }
        }
        prefetch_retire(pfd);
        __syncthreads();
    }
    float* Pb = p.out;
    float* Ub = p.out + (size_t)NCHUNK * 16 * 4096;
    const size_t off = ((size_t)((c * 8 + h) * 2 + d)) * 4096 + rp * 64 + cb;
#pragma unroll
    for (int j4 = 0; j4 < 4; ++j4) {
        *(f32x4*)(Pb + off + j4 * 4) = (f32x4){Sp[2 * j4][0], Sp[2 * j4][1], Sp[2 * j4 + 1][0], Sp[2 * j4 + 1][1]};
        *(f32x4*)(Ub + off + j4 * 4) = (f32x4){Su[2 * j4][0], Su[2 * j4][1], Su[2 * j4 + 1][0], Su[2 * j4 + 1][1]};
    }
}
DEV void l1_item(const Params& p, int item, unsigned char* ldsb) { if ((item >> 3) & 1) l1_body<1>(p, item, ldsb); else l1_body<0>(p, item, ldsb); }

DEV void l2_item(const Params& p, int seq, int h, int d, int rb, unsigned char* ldsb) {
    float* srow = (float*)ldsb;
    float* pst = (float*)(ldsb + 2048);
    const float* Pb = p.out;
    float* Ub = p.out + (size_t)NCHUNK * 16 * 4096;
    int cbeg, nc;
    if (seq == 0) { cbeg = 0; nc = NTP / CH; } else { cbeg = NTP / CH + (seq - 1) * (2048 / CH); nc = 2048 / CH; }
    const int tid = VT, row = tid >> 5, cg2 = (tid & 31) * 2, grow = rb * 8 + row;
    const int cstep = d ? -1 : 1, cfirst = d ? cbeg + nc - 1 : cbeg;
    const size_t hd = (size_t)(h * 2 + d) * 4096, cstride = (size_t)16 * 4096;
    float sx = 0.f, sy = 0.f;
    f32x4 pa[4], pb[4];
    f32x2 ucur, unext = (f32x2){0.f, 0.f}, unn = unext;
    {
        const float* src = Pb + (size_t)cfirst * cstride + hd;
#pragma unroll
        for (int i = 0; i < 4; ++i) *(f32x4*)(pst + (tid + 256 * i) * 4) = *(const f32x4*)(src + (tid + 256 * i) * 4);
        ucur = *(const f32x2*)(Ub + (size_t)cfirst * cstride + hd + grow * 64 + cg2);
        if (nc > 1) {
            const size_t b1 = (size_t)(cfirst + cstep) * cstride + hd;
#pragma unroll
            for (int i = 0; i < 4; ++i) pa[i] = *(const f32x4*)(Pb + b1 + (tid + 256 * i) * 4);
            unext = *(const f32x2*)(Ub + b1 + grow * 64 + cg2);
        }
    }
#pragma unroll 1
    for (int ci = 0; ci < nc; ++ci) {
        const int c = cfirst + ci * cstep;
        const size_t base = (size_t)c * cstride + hd;
        if (ci + 2 < nc) {
            const size_t b2 = (size_t)(c + 2 * cstep) * cstride + hd;
#pragma unroll
            for (int i = 0; i < 4; ++i) pb[i] = *(const f32x4*)(Pb + b2 + (tid + 256 * i) * 4);
            unn = *(const f32x2*)(Ub + b2 + grow * 64 + cg2);
        }
        *(f32x2*)(Ub + base + grow * 64 + cg2) = (f32x2){sx, sy};
        *(f32x2*)(srow + row * 64 + cg2) = (f32x2){sx, sy};
        __syncthreads();
        const float* ps = pst + (ci & 1) * 4096 + cg2;
        f32x2 a0 = ucur, a1 = (f32x2){0.f, 0.f}, a2 = a1, a3 = a1;
#pragma unroll 4
        for (int k4 = 0; k4 < 16; ++k4) {
            const f32x4 sv = *(const f32x4*)(srow + row * 64 + k4 * 4);
            a0 += sv[0] * *(const f32x2*)(ps + (k4 * 4 + 0) * 64);
            a1 += sv[1] * *(const f32x2*)(ps + (k4 * 4 + 1) * 64);
            a2 += sv[2] * *(const f32x2*)(ps + (k4 * 4 + 2) * 64);
            a3 += sv[3] * *(const f32x2*)(ps + (k4 * 4 + 3) * 64);
        }
        if (ci + 1 < nc) {
            float* dstp = pst + ((ci + 1) & 1) * 4096;
#pragma unroll
            for (int i = 0; i < 4; ++i) *(f32x4*)(dstp + (tid + 256 * i) * 4) = pa[i];
        }
        __syncthreads();
        sx = (a0[0] + a1[0]) + (a2[0] + a3[0]);
        sy = (a0[1] + a1[1]) + (a2[1] + a3[1]);
        ucur = unext; unext = unn;
#pragma unroll
        for (int i = 0; i < 4; ++i) pa[i] = pb[i];
    }
}

DEV void na_item(const Params& p, int item, unsigned char* ldsb, bool to_ua);
DEV void phase_l2(const Params& p, unsigned char* lds) {
    const int G = VG, b = VB;
    constexpr int N_NA = 768 * 8;
    if (G >= 256) {
        constexpr int N_NA_CHAIN = 1024;
        if (b < 128) {
            if (!SKIP_SCAN) l2_item(p, 0, (b >> 4) & 7, (b >> 3) & 1, b & 7, lds);
            __syncthreads();
            if (!SKIP_NA) for (int it = b; it < N_NA_CHAIN; it += 128) { na_item(p, it, lds, false); __syncthreads(); }
        } else {
            if (!SKIP_SCAN) for (int it = b - 128; it < 2048; it += G - 128) l2_item(p, 1 + (it >> 7), (it >> 4) & 7, (it >> 3) & 1, it & 7, lds);
            __syncthreads();
            if (!SKIP_NA) for (int it = N_NA_CHAIN + b - 128; it < N_NA; it += G - 128) { na_item(p, it, lds, false); __syncthreads(); }
        }
    } else {
        if (!SKIP_SCAN) for (int it = b; it < 2176; it += G) l2_item(p, it >> 7, (it >> 4) & 7, (it >> 3) & 1, it & 7, lds);
        __syncthreads();
        if (!SKIP_NA) for (int it = b; it < N_NA; it += G) { na_item(p, it, lds, false); __syncthreads(); }
    }
}

DEV float reduce8(float v) { v += dpp_x1(v); v += dpp_x2(v); v += dpp_hm(v); return v; }
template <int d>
DEV void l3_pass(const Params& p, float* lds, int h, int c, int t0, int sstart, int send) {
    const int tid = VT, rp = tid >> 3, part = tid & 7, cb = part * 8;
    const float* Sb = p.out + (size_t)NCHUNK * 16 * 4096;
    float* yfg = p.out + (size_t)NT * 512;
    bf16_t* ua = (bf16_t*)(p.ws + OFF_UA);
    LoraFrag lf; lora_load<true, d>(p, lf, h);
    {
        f32x2 S0[4], S1[4];
        {
            const float* src = Sb + ((size_t)((c * 8 + h) * 2 + d)) * 4096 + rp * 64 + cb;
#pragma unroll
            for (int j4 = 0; j4 < 2; ++j4) {
                const f32x4 v = *(const f32x4*)(src + j4 * 4), u = *(const f32x4*)(src + 32 * 64 + j4 * 4);
                S0[2 * j4] = (f32x2){v[0], v[1]}; S0[2 * j4 + 1] = (f32x2){v[2], v[3]};
                S1[2 * j4] = (f32x2){u[0], u[1]}; S1[2 * j4 + 1] = (f32x2){u[2], u[3]};
            }
        }
#pragma unroll 1
        for (int sci = 0; sci < NSUB; ++sci) {
            const int sc = d ? NSUB - 1 - sci : sci;
            scan_prep<true, d>(p, lds, lf, t0 + sc * 16, sc * 16, h, sstart, send);
            const unsigned pfd = prefetch_touch((const bf16_t*)(p.ws + OFF_Z), t0 + (sci + 1 < NSUB ? (d ? sc - 1 : sc + 1) : sc) * 16, h, d, sstart, send);
#pragma unroll 1
            for (int sti = 0; sti < 16; ++sti) {
                const int tl = d ? 15 - sti : sti;
                const float* ap = lds + L_AA + tl * 64 + cb;
                const float* wp = lds + L_WD + tl * 64 + cb;
                const float* bp = lds + L_BD + tl * 64 + cb;
                const float* kp = lds + L_KD + tl * 64 + cb;
                const float* rq = lds + L_RR + tl * 64 + cb;
                f32x2 da0 = (f32x2){0.f, 0.f}, da1 = da0, dy0 = da0, dy1 = da0;
#pragma unroll
                for (int j4 = 0; j4 < 2; ++j4) {
                    const f32x4 a = *(const f32x4*)(ap + j4 * 4);
                    const f32x2 a0 = (f32x2){a[0], a[1]}, a1 = (f32x2){a[2], a[3]};
                    da0 += S0[2 * j4] * a0; da1 += S1[2 * j4] * a0; da0 += S0[2 * j4 + 1] * a1; da1 += S1[2 * j4 + 1] * a1;
                    if (d) {
                        const f32x4 r = *(const f32x4*)(rq + j4 * 4);
                        const f32x2 r0 = (f32x2){r[0], r[1]}, r1 = (f32x2){r[2], r[3]};
                        dy0 += S0[2 * j4] * r0; dy1 += S1[2 * j4] * r0; dy0 += S0[2 * j4 + 1] * r1; dy1 += S1[2 * j4 + 1] * r1;
                    }
                }
                const float sa0 = reduce8(da0[0] + da0[1]), sa1 = reduce8(da1[0] + da1[1]);
                const float vv0 = lds[L_VV + tl * 64 + rp], vv1 = lds[L_VV + tl * 64 + rp + 32];
#pragma unroll
                for (int j4 = 0; j4 < 2; ++j4) {
                    const f32x4 w = *(const f32x4*)(wp + j4 * 4), b = *(const f32x4*)(bp + j4 * 4), k = *(const f32x4*)(kp + j4 * 4);
                    const f32x2 w0 = (f32x2){w[0], w[1]}, w1 = (f32x2){w[2], w[3]}, b0 = (f32x2){b[0], b[1]}, b1 = (f32x2){b[2], b[3]}, k0 = (f32x2){k[0], k[1]}, k1 = (f32x2){k[2], k[3]};
                    const f32x2 s00 = S0[2 * j4] * w0 + (sa0 * b0 + vv0 * k0), s01 = S0[2 * j4 + 1] * w1 + (sa0 * b1 + vv0 * k1);
                    const f32x2 s10 = S1[2 * j4] * w0 + (sa1 * b0 + vv1 * k0), s11 = S1[2 * j4 + 1] * w1 + (sa1 * b1 + vv1 * k1);
                    S0[2 * j4] = s00; S0[2 * j4 + 1] = s01; S1[2 * j4] = s10; S1[2 * j4 + 1] = s11;
                    if (!d) {
                        const f32x4 r = *(const f32x4*)(rq + j4 * 4);
                        const f32x2 r0 = (f32x2){r[0], r[1]}, r1 = (f32x2){r[2], r[3]};
                        dy0 += s00 * r0; dy0 += s01 * r1; dy1 += s10 * r0; dy1 += s11 * r1;
                    }
                }
                const float y0 = reduce8(dy0[0] + dy0[1]), y1 = reduce8(dy1[0] + dy1[1]);
                if (part == 0) {
                    if (d) { lds[L_O + tl * 64 + rp] = y0; lds[L_O + tl * 64 + rp + 32] = y1; }
                    else { float* yq = yfg + (size_t)(t0 + sc * 16 + tl) * 512 + h * 64 + rp; yq[0] = y0; yq[32] = y1; }
                }
            }
            prefetch_retire(pfd);
            __syncthreads();
            if (d == 1) {
                const int tt = tid >> 4, q16 = tid & 15, j0 = q16 * 4, c0 = h * 64 + j0, tloc = sc * 16 + tt;
                const f32x4 ov = *(const f32x4*)(lds + L_O + tt * 64 + j0) + *(const f32x4*)(yfg + (size_t)(t0 + tloc) * 512 + c0);
                const float mean = sum16(ov[0] + ov[1] + ov[2] + ov[3]) * (1.f / 64.f);
                const f32x4 dv = ov - mean;
                const float var = sum16(dv[0] * dv[0] + dv[1] * dv[1] + dv[2] * dv[2] + dv[3] * dv[3]) * (1.f / 64.f);
                const float rstd = 1.0f / sqrtf(var + 64e-5f);
                const f32x4 lw = *(const f32x4*)(p.in[20] + c0), lb = *(const f32x4*)(p.in[21] + c0);
                const float bdot = lds[L_BDOT + tloc];
                const f32x4 v4 = *(const f32x4*)(lds + L_VV + tt * 64 + j0);
                const f32x4 g = *(const f32x4*)(lds + L_LG + tt * 64 + j0);
                const f32x4 res = (dv * rstd * lw + lb + bdot * v4) * g;
                st4bf(ua + (size_t)(t0 + tloc) * 512 + c0, res);
                __syncthreads();
            }
        }
    }
}

DEV void l3_item(const Params& p, int item, unsigned char* ldsb) {
    float* lds = (float*)ldsb;
    const int h = item & 7, c = item >> 3, t0 = c * CH;
    int sstart, send; seq_bounds(t0, sstart, send);
    if (VT < CH) lds[L_BDOT + VT] = 0.f;
    l3_pass<0>(p, lds, h, c, t0, sstart, send);
    l3_pass<1>(p, lds, h, c, t0, sstart, send);
}

DEV void na_item(const Params& p, int item, unsigned char* ldsb, bool to_ua) {
    const int h = item & 7, grow = item >> 3;
    int tok0, rows, r;
    if (grow < 256) { tok0 = 0; rows = 256; r = grow; } else { const int g = grow - 256; tok0 = NTP + (g >> 5) * 2048; rows = 32; r = g & 31; }
    int rs = r - 4; rs = rs < 0 ? 0 : rs; rs = rs > rows - 8 ? rows - 8 : rs;
    bf16_t* z = (bf16_t*)(p.ws + OFF_Z);
    float* rpb_l = (float*)ldsb;
    bf16_t* vt = (bf16_t*)(ldsb + 2048);
    const float* rpb = p.in[22] + h * 465;
    const int tid = VT, w = tid >> 6, lane = tid & 63, fr = lane & 15, fq = lane >> 4;
    for (int i = tid; i < 465; i += 256) rpb_l[i] = rpb[i];
    const int qtok = tok0 + r * 64 + w * 16 + fr;
    bf16x8 qf[2];
#pragma unroll
    for (int ks = 0; ks < 2; ++ks) qf[ks] = *(const bf16x8*)(z + (size_t)qtok * ZW + 1920 + h * 64 + ks * 32 + fq * 8);
    const int kb0 = (w < 2) ? 0 : 1;
    f32x4 sc[8][3];
#pragma unroll
    for (int i = 0; i < 8; ++i)
#pragma unroll
        for (int kb = 0; kb < 3; ++kb) {
            const int ktok = tok0 + (rs + i) * 64 + (kb0 + kb) * 16 + fr;
            f32x4 acc = (f32x4){0.f, 0.f, 0.f, 0.f};
#pragma unroll
            for (int ks = 0; ks < 2; ++ks) {
                const bf16x8 kf = *(const bf16x8*)(z + (size_t)ktok * ZW + 2432 + h * 64 + ks * 32 + fq * 8);
                acc = __builtin_amdgcn_mfma_f32_16x16x32_bf16(kf, qf[ks], acc, 0, 0, 0);
            }
            sc[i][kb] = acc;
        }
    const int kp = tid & 31, dg = tid >> 5;
    __syncthreads();
    u32x4 vr[3][2];
    const bf16_t* vbase = z + (size_t)(tok0 + rs * 64 + 2 * kp) * ZW + 2944 + h * 64 + dg * 8;
#pragma unroll
    for (int i = 0; i < 3; ++i) { vr[i][0] = *(const u32x4*)(vbase + (size_t)i * 64 * ZW); vr[i][1] = *(const u32x4*)(vbase + (size_t)i * 64 * ZW + ZW); }
    const int qc = w * 16 + fr;
    int cs = qc - 8; cs = cs < 0 ? 0 : cs; cs = cs > 48 ? 48 : cs;
    float mx = -1e30f;
#pragma unroll
    for (int i = 0; i < 8; ++i)
#pragma unroll
        for (int kb = 0; kb < 3; ++kb)
#pragma unroll
            for (int j = 0; j < 4; ++j) {
                const int kc = (kb0 + kb) * 16 + fq * 4 + j;
                const bool valid = (kc >= cs) && (kc < cs + 16);
                const int dr = rs + i - r + 7, dc = kc - qc + 15;
                const float s = valid ? sc[i][kb][j] * 0.125f + rpb_l[dr * 31 + (valid ? dc : 0)] : -1e30f;
                sc[i][kb][j] = s;
                mx = fmaxf(mx, s);
            }
    mx = fmaxf(mx, __shfl_xor(mx, 16)); mx = fmaxf(mx, __shfl_xor(mx, 32));
    float sum = 0.f;
#pragma unroll
    for (int i = 0; i < 8; ++i)
#pragma unroll
        for (int kb = 0; kb < 3; ++kb)
#pragma unroll
            for (int j = 0; j < 4; ++j) { const float e = __expf(sc[i][kb][j] - mx); sc[i][kb][j] = e; sum += e; }
    sum += __shfl_xor(sum, 16); sum += __shfl_xor(sum, 32);
    const float inv = 1.f / sum;
    f32x4 oacc[4];
#pragma unroll
    for (int dt = 0; dt < 4; ++dt) oacc[dt] = (f32x4){0.f, 0.f, 0.f, 0.f};
#pragma unroll
    for (int i = 0; i < 8; ++i) {
        unsigned* vts = (unsigned*)(vt + (i & 1) * (64 * 72));
#pragma unroll
        for (int e = 0; e < 4; ++e) {
            const unsigned a = vr[i % 3][0][e], b2 = vr[i % 3][1][e];
            vts[((dg * 8 + 2 * e) * 72 + 2 * kp) >> 1] = (a & 0xffffu) | (b2 << 16);
            vts[((dg * 8 + 2 * e + 1) * 72 + 2 * kp) >> 1] = (a >> 16) | (b2 & 0xffff0000u);
        }
        if (i + 3 < 8) { vr[i % 3][0] = *(const u32x4*)(vbase + (size_t)(i + 3) * 64 * ZW); vr[i % 3][1] = *(const u32x4*)(vbase + (size_t)(i + 3) * 64 * ZW + ZW); }
        __syncthreads();
        const bf16_t* vtr = vt + (i & 1) * (64 * 72);
#pragma unroll
        for (int kb = 0; kb < 3; ++kb) {
            u32x2 pu; pu.x = pk2(sc[i][kb][0], sc[i][kb][1]); pu.y = pk2(sc[i][kb][2], sc[i][kb][3]);
            const bf16x4 pb = __builtin_bit_cast(bf16x4, pu);
#pragma unroll
            for (int dt = 0; dt < 4; ++dt) {
                const bf16x4 a = *(const bf16x4*)(vtr + (dt * 16 + fr) * 72 + (kb0 + kb) * 16 + fq * 4);
                oacc[dt] = __builtin_amdgcn_mfma_f32_16x16x16bf16_1k(a, pb, oacc[dt], 0, 0, 0);
            }
        }
    }
    __syncthreads();
    bf16_t* dstp = to_ua ? (bf16_t*)(p.ws + OFF_UA) + (size_t)qtok * 512 + h * 64 : z + (size_t)qtok * ZW + 1920 + h * 64;
#pragma unroll
    for (int dt = 0; dt < 4; ++dt) st4bf(dstp + dt * 16 + fq * 4, oacc[dt] * inv);
}

DEV void phase2(const Params& p, unsigned char* lds) {
    constexpr int N_L1 = NCHUNK * 16;
    for (int it = VB; it < N_L1; it += VG) {
        if (!SKIP_SCAN) { l1_item(p, it, lds); if (REP_SCAN) { __syncthreads(); l1_item(p, it, lds); } }
        __syncthreads();
    }
}
DEV void phase4(const Params& p, unsigned char* lds) {
    for (int it = VB; it < NCHUNK * 8; it += VG) { l3_item(p, it, lds); __syncthreads(); if (REP_SCAN) { l3_item(p, it, lds); __syncthreads(); } }
}

DEV void tile256_put(unsigned char* lds, int rl, int cl, u32x2 u) { *(u32x2*)(lds + rl * 512 + (((cl >> 3) ^ (rl & 31)) << 4) + ((cl & 7) << 1)) = u; }
DEV void tile256_flush(unsigned char* lds, bf16_t* dst, int ld, int row0, int col0, int oz) {
    __syncthreads();
#pragma unroll
    for (int k = 0; k < 16; ++k) {
        const int idx = (int)threadIdx.x + 512 * k + oz, rl = idx >> 5, ch = idx & 31;
        const u32x4 v = *(const u32x4*)(lds + rl * 512 + ((ch ^ (rl & 31)) << 4));
        *(u32x4*)(dst + (size_t)(row0 + rl) * ld + col0 + ch * 8) = v;
    }
    __syncthreads();
}

template <bool ADD>
DEV void tile256_gate_bf16(unsigned char* lds, const bf16_t* gate, const bf16_t* addend, bf16_t* dst, int ld, const f32x4 (&acc)[8][4], int oz) {
    const int tid = threadIdx.x, wid = tid >> 6, lane = tid & 63, wr = wid >> 2, wc = wid & 3, fr = lane & 15, fq = lane >> 4;
#pragma unroll
    for (int half = 0; half < 2; ++half) {
        asm volatile("s_waitcnt vmcnt(0)" ::: "memory");
#pragma unroll 2
        for (int i = 0; i < 8; ++i) {
            const int r0 = wid * 16 + 2 * i + oz, rl = r0 + (lane >> 5);
            const size_t go = (size_t)(half * 128 + rl) * ld + (((lane & 31) ^ (rl & 31)) << 3);
            __builtin_amdgcn_global_load_lds((const unsigned*)(gate + go), (unsigned*)(lds + r0 * 512), 16, 0, 0);
            if (ADD) __builtin_amdgcn_global_load_lds((const unsigned*)(addend + go), (unsigned*)(lds + 65536 + r0 * 512), 16, 0, 0);
        }
        asm volatile("s_waitcnt vmcnt(0)" ::: "memory");
        __syncthreads();
        if (wr == half) {
#pragma unroll
            for (int m = 0; m < 8; ++m)
#pragma unroll
                for (int n = 0; n < 4; ++n) {
                    const int rl = m * 16 + fr + oz, cl = wc * 64 + n * 16 + fq * 4;
                    unsigned char* q = lds + rl * 512 + (((cl >> 3) ^ (rl & 31)) << 4) + ((cl & 7) << 1);
                    const u32x2 gu = *(const u32x2*)q;
                    f32x4 v = (f32x4){bf_lo(gu.x), bf_hi(gu.x), bf_lo(gu.y), bf_hi(gu.y)} * acc[m][n];
                    if (ADD) { const u32x2 mu = *(const u32x2*)(q + 65536); v += (f32x4){bf_lo(mu.x), bf_hi(mu.x), bf_lo(mu.y), bf_hi(mu.y)}; }
                    u32x2 o; o.x = pk2(v[0], v[1]); o.y = pk2(v[2], v[3]);
                    *(u32x2*)q = o;
                }
        }
        __syncthreads();
#pragma unroll 4
        for (int k = 0; k < 8; ++k) {
            const int idx = tid + 512 * k + oz, rl = idx >> 5, ch = idx & 31;
            const u32x4 v = *(const u32x4*)(lds + rl * 512 + ((ch ^ (rl & 31)) << 4));
            *(u32x4*)(dst + (size_t)(half * 128 + rl) * ld + ch * 8) = v;
        }
        __syncthreads();
    }
}

DEV void phase5(const Params& p, unsigned char* lds_all) {
    const bf16_t* hmix = (const bf16_t*)(p.ws + OFF_HMIX);
    const bf16_t* wt = (const bf16_t*)(p.ws + OFF_WIN_T);
    const bf16_t* wa = (const bf16_t*)(p.ws + OFF_WBRA_T);
    const bf16_t* wn = (const bf16_t*)(p.ws + OFF_WBRN_T);
    const bf16_t* ua = (const bf16_t*)(p.ws + OFF_UA);
    const bf16_t* z = (const bf16_t*)(p.ws + OFF_Z);
    bf16_t* mb = (bf16_t*)p.out;
    bf16_t* tb = (bf16_t*)((unsigned char*)p.out + OUT_PBF);
    TileIter256 ti; ti.init(NT / 256, 4);
    for (int tm_, tn_; ti.next(tm_, tn_);) {
        const int row0 = tm_ * 256, col0 = tn_ * 256;
        EPI256_COORDS
        f32x4 acc[8][4];
        zero_acc256(acc); gemm256_acc(acc, hmix + (size_t)row0 * DM, DM, wt + (size_t)(ZW + col0) * DM, DM, DM, lds_all);
        int oz1; asm volatile("s_mov_b32 %0, 0" : "=s"(oz1));
#pragma unroll
        for (int m = 0; m < 8; ++m)
#pragma unroll
            for (int n = 0; n < 4; ++n) {
                f32x4 v;
#pragma unroll
                for (int j = 0; j < 4; ++j) v[j] = sigmoidf_(acc[m][n][j]);
                u32x2 u; u.x = pk2(v[0], v[1]); u.y = pk2(v[2], v[3]);
                tile256_put(lds_all, wr_ * 128 + m * 16 + fr_ + oz1, wc_ * 64 + n * 16 + fq_ * 4, u);
            }
        tile256_flush(lds_all, mb, DM, row0, col0, oz1);
        zero_acc256(acc); gemm256_acc(acc, ua + (size_t)row0 * 512, 512, wa + (size_t)col0 * 512, 512, 512, lds_all);
        int oz2; asm volatile("s_mov_b32 %0, 0" : "=s"(oz2));
        { bf16_t* mt = mb + (size_t)row0 * DM + col0; tile256_gate_bf16<false>(lds_all, mt, mt, mt, DM, acc, oz2); }
        zero_acc256(acc); gemm256_acc(acc, hmix + (size_t)row0 * DM, DM, wt + (size_t)(ZW + 1024 + col0) * DM, DM, DM, lds_all);
        int oz3; asm volatile("s_mov_b32 %0, 0" : "=s"(oz3));
#pragma unroll
        for (int m = 0; m < 8; ++m)
#pragma unroll
            for (int n = 0; n < 4; ++n) {
                f32x4 v;
#pragma unroll
                for (int j = 0; j < 4; ++j) v[j] = sigmoidf_(acc[m][n][j]);
                u32x2 u; u.x = pk2(v[0], v[1]); u.y = pk2(v[2], v[3]);
                tile256_put(lds_all, wr_ * 128 + m * 16 + fr_ + oz3, wc_ * 64 + n * 16 + fq_ * 4, u);
            }
        tile256_flush(lds_all, tb, DM, row0, col0, oz3);
        zero_acc256(acc); gemm256_acc(acc, z + (size_t)row0 * ZW + 1920, ZW, wn + (size_t)col0 * 512, 512, 512, lds_all);
        int oz4; asm volatile("s_mov_b32 %0, 0" : "=s"(oz4));
        { bf16_t* mt = mb + (size_t)row0 * DM + col0; tile256_gate_bf16<true>(lds_all, tb + (size_t)row0 * DM + col0, mt, mt, DM, acc, oz4); }
    }
}

template <bool GATE = false>
DEV void tile256_resid_f32(unsigned char* lds, const float* src, float* dst, const f32x4 (&acc)[8][4], int oz, const bf16_t* gate = nullptr) {
    const int tid = threadIdx.x, wid = tid >> 6, lane = tid & 63, wr = wid >> 2, wc = wid & 3, fr = lane & 15, fq = lane >> 4;
#pragma unroll
    for (int half = 0; half < 2; ++half) {
        asm volatile("s_waitcnt vmcnt(0)" ::: "memory");
#pragma unroll 2
        for (int i = 0; i < 16; ++i) {
            const int rl = wid * 16 + i + oz;
            const float* g = src + (size_t)(half * 128 + rl) * DM + ((lane ^ (rl & 63)) << 2);
            __builtin_amdgcn_global_load_lds((const unsigned*)g, (unsigned*)(lds + rl * 1024), 16, 0, 0);
        }
        asm volatile("s_waitcnt vmcnt(0)" ::: "memory");
        __syncthreads();
        if (wr == half) {
#pragma unroll
            for (int m = 0; m < 8; ++m)
#pragma unroll
                for (int n = 0; n < 4; ++n) {
                    const int rl = m * 16 + fr + oz, ch = (wc * 64 + n * 16 + fq * 4) >> 2;
                    f32x4* q = (f32x4*)(lds + rl * 1024 + ((ch ^ (rl & 63)) << 4));
                    f32x4 a = acc[m][n];
                    if (GATE) a = a * ld4bf(gate + (size_t)(half * 128 + rl) * DM + ch * 4);
                    *q = *q + a;
                }
        }
        __syncthreads();
#pragma unroll 4
        for (int k = 0; k < 16; ++k) {
            const int idx = tid + 512 * k + oz, rl = idx >> 6, ch = idx & 63;
            const f32x4 v = *(const f32x4*)(lds + rl * 1024 + ((ch ^ (rl & 63)) << 4));
            *(f32x4*)(dst + (size_t)(half * 128 + rl) * DM + ch * 4) = v;
        }
        __syncthreads();
    }
}

DEV void phase6(const Params& p, unsigned char* lds_all) {
    const bf16_t* mb = (const bf16_t*)p.out;
    const bf16_t* wo = (const bf16_t*)(p.ws + OFF_WOUT_T);
    float* x1 = (float*)(p.ws + OFF_X1);
    TileIter256 ti; ti.init(NT / 256, 4);
    for (int tm_, tn_; ti.next(tm_, tn_);) {
        const int row0 = tm_ * 256, col0 = tn_ * 256;
        f32x4 acc[8][4]; zero_acc256(acc);
        gemm256_acc(acc, mb + (size_t)row0 * DM, DM, wo + (size_t)col0 * DM, DM, DM, lds_all);
        int oz; asm volatile("s_mov_b32 %0, 0" : "=s"(oz));
        tile256_resid_f32(lds_all, xrow(p, row0) + col0, x1 + (size_t)row0 * DM + col0, acc, oz);
    }
}

DEV void phase_norm(const Params& p, const float* g, bool with_p) {
    const float* x1 = (const float*)(p.ws + OFF_X1);
    bf16_t* hb = (bf16_t*)p.out;
    const int wave = VT >> 6, lane = VT & 63;
    for (int t = VB * 4 + wave; t < NT; t += VG * 4) {
        norm_row_bf16(x1 + (size_t)t * DM, g, hb + (size_t)t * DM, lane);
        if (with_p) {
            bf16_t* pb = (bf16_t*)((unsigned char*)p.out + OUT_PBF);
            const f32x4 v = *(const f32x4*)(prow(p, t) + lane * 4);
            st4bf(pb + (size_t)t * 256 + lane * 4, v);
        }
    }
}

DEV void phase8(const Params& p, unsigned char* lds_all) {
    const bf16_t* h2 = (const bf16_t*)p.out;
    const bf16_t* wgu = (const bf16_t*)(p.ws + OFF_WGATE_T);
    bf16_t* act = (bf16_t*)(p.ws + OFF_ACT);
    TileIter256 ti; ti.init(NT / 256, 2 * DFF / 256);
    for (int tm_, tn_; ti.next(tm_, tn_);) {
        const int row0 = tm_ * 256, col0 = tn_ * 256;
        f32x4 acc[8][4]; zero_acc256(acc);
        gemm256_acc(acc, h2 + (size_t)row0 * DM, DM, wgu + (size_t)col0 * DM, DM, DM, lds_all);
        EPI256_COORDS
        int oz; asm volatile("s_mov_b32 %0, 0" : "=s"(oz));
#pragma unroll
        for (int m = 0; m < 8; ++m)
#pragma unroll
            for (int q = 0; q < 2; ++q) {
                f32x4 v;
#pragma unroll
                for (int j = 0; j < 4; ++j) { const float gq = acc[m][2 * q][j]; v[j] = gq * sigmoidf_(gq) * acc[m][2 * q + 1][j]; }
                const int rl = wr_ * 128 + m * 16 + fr_ + oz, cl = wc_ * 32 + q * 16 + fq_ * 4;
                u32x2 u; u.x = pk2(v[0], v[1]); u.y = pk2(v[2], v[3]);
                *(u32x2*)(lds_all + rl * 256 + (((cl >> 3) ^ (rl & 15)) << 4) + ((cl & 7) << 1)) = u;
            }
        __syncthreads();
#pragma unroll
        for (int k = 0; k < 8; ++k) {
            const int idx = tid_ + 512 * k + oz, rl = idx >> 4, ch = idx & 15;
            const u32x4 v = *(const u32x4*)(lds_all + rl * 256 + ((ch ^ (rl & 15)) << 4));
            *(u32x4*)(act + (size_t)(row0 + rl) * DFF + tn_ * 128 + ch * 8) = v;
        }
        __syncthreads();
    }
}

DEV void phase9(const Params& p, unsigned char* lds_all) {
    const bf16_t* act = (const bf16_t*)(p.ws + OFF_ACT);
    const bf16_t* wd = (const bf16_t*)(p.ws + OFF_WDOWN_T);
    float* x1 = (float*)(p.ws + OFF_X1);
    TileIter256 ti; ti.init(NT / 256, 4);
    for (int tm_, tn_; ti.next(tm_, tn_);) {
        const int row0 = tm_ * 256, col0 = tn_ * 256;
        f32x4 acc[8][4]; zero_acc256(acc);
        gemm256_acc(acc, act + (size_t)row0 * DFF, DFF, wd + (size_t)col0 * DFF, DFF, DFF, lds_all);
        int oz; asm volatile("s_mov_b32 %0, 0" : "=s"(oz));
        float* xt = x1 + (size_t)row0 * DM + col0;
        tile256_resid_f32(lds_all, xt, xt, acc, oz);
    }
}

DEV void phase11(const Params& p, unsigned char* lds_all) {
    const bf16_t* h3 = (const bf16_t*)p.out;
    const bf16_t* pb = (const bf16_t*)((const unsigned char*)p.out + OUT_PBF);
    const bf16_t* wp = (const bf16_t*)(p.ws + OFF_WPLE_T);
    const bf16_t* wg = (const bf16_t*)(p.ws + OFF_WPG_T);
    bf16_t* tb = (bf16_t*)(p.ws + OFF_ACT);
    float* x1 = (float*)(p.ws + OFF_X1);
    TileIter256 ti; ti.init(NT / 256, 4);
    for (int tm_, tn_; ti.next(tm_, tn_);) {
        const int row0 = tm_ * 256, col0 = tn_ * 256;
        EPI256_COORDS
        f32x4 acc[8][4];
        zero_acc256(acc); gemm256_acc(acc, h3 + (size_t)row0 * DM, DM, wg + (size_t)col0 * DM, DM, DM, lds_all);
        int oz1; asm volatile("s_mov_b32 %0, 0" : "=s"(oz1));
#pragma unroll
        for (int m = 0; m < 8; ++m)
#pragma unroll
            for (int n = 0; n < 4; ++n) {
                f32x4 v;
#pragma unroll
                for (int j = 0; j < 4; ++j) v[j] = sigmoidf_(acc[m][n][j]);
                u32x2 u; u.x = pk2(v[0], v[1]); u.y = pk2(v[2], v[3]);
                tile256_put(lds_all, wr_ * 128 + m * 16 + fr_ + oz1, wc_ * 64 + n * 16 + fq_ * 4, u);
            }
        tile256_flush(lds_all, tb, DM, row0, col0, oz1);
        zero_acc256(acc); gemm256_acc(acc, pb + (size_t)row0 * 256, 256, wp + (size_t)col0 * 256, 256, 256, lds_all);
        int oz2; asm volatile("s_mov_b32 %0, 0" : "=s"(oz2));
        { float* xt = x1 + (size_t)row0 * DM + col0; tile256_resid_f32<true>(lds_all, xt, xt, acc, oz2, tb + (size_t)row0 * DM + col0); }
    }
}

DEV void phase12(const Params& p) {
    const float* x1 = (const float*)(p.ws + OFF_X1);
    const int wave = VT >> 6, lane = VT & 63;
    for (int t = VB * 4 + wave; t < NT; t += VG * 4) norm_row_f32(x1 + (size_t)t * DM, p.in[33], p.out + (size_t)t * DM, lane);
}

DEV void fast_barrier(unsigned* cnt, unsigned target) {
    asm volatile("s_waitcnt vmcnt(0)" ::: "memory");
    __syncthreads();
    if (threadIdx.x == 0) {
        __builtin_amdgcn_fence(__ATOMIC_RELEASE, "agent");
        asm volatile("s_waitcnt vmcnt(0)" ::: "memory");
        __hip_atomic_fetch_add(cnt, 1u, __ATOMIC_RELAXED, __HIP_MEMORY_SCOPE_AGENT);
        while (__hip_atomic_load(cnt, __ATOMIC_RELAXED, __HIP_MEMORY_SCOPE_AGENT) < target) __builtin_amdgcn_s_sleep(1);
        __builtin_amdgcn_fence(__ATOMIC_ACQUIRE, "agent");
        asm volatile("s_waitcnt vmcnt(0)" ::: "memory");
    }
    __syncthreads();
}

__global__ void __launch_bounds__(512) mega(Params p) {
    extern __shared__ __attribute__((aligned(16))) unsigned char lds_all[];
    unsigned char* lds = lds_all + (threadIdx.x >> 8) * 65536;
    cg::grid_group grid = cg::this_grid();
#define PH(n) if (p.ph_lo <= (n) && (n) < p.ph_hi)
#define GS(n) if (p.ph_lo <= (n) && (n) + 1 < p.ph_hi) { if ((n) == 0) grid.sync(); else fast_barrier((unsigned*)p.ws, (unsigned)(n) * gridDim.x); }
    PH(0) { phase0(p, lds); if (REP_MISC) { __syncthreads(); phase0(p, lds); } }
    GS(0)
    PH(1) { phase1(p, lds_all); if (REP_GEMM) phase1(p, lds_all); }
    GS(1)
    PH(2) phase2(p, lds);
    GS(2)
    PH(3) phase_l2(p, lds);
    GS(3)
    PH(4) { if (!SKIP_SCAN) phase4(p, lds); }
    GS(4)
    PH(5) { phase5(p, lds_all); if (REP_GEMM) phase5(p, lds_all); }
    GS(5)
    PH(6) { phase6(p, lds_all); if (REP_GEMM) phase6(p, lds_all); }
    GS(6)
    PH(7) { phase_norm(p, p.in[26], true); if (REP_MISC) phase_norm(p, p.in[26], true); }
    GS(7)
    PH(8) { phase8(p, lds_all); if (REP_GEMM) phase8(p, lds_all); }
    GS(8)
    PH(9) phase9(p, lds_all);
    GS(9)
    PH(10) { phase_norm(p, p.in[30], false); if (REP_MISC) phase_norm(p, p.in[30], false); }
    GS(10)
    PH(11) phase11(p, lds_all);
    GS(11)
    PH(12) { phase12(p); if (REP_MISC) phase12(p); }
}

extern "C" void kernel_launch(void* const* d_in, const int* in_sizes, int n_in, void* d_out, int out_size, void* d_ws, size_t ws_size, hipStream_t stream) {
    static int grid_blocks = 0;
    if (!grid_blocks) {
        int dev = 0, cus = 0, per_cu = 0;
        hipGetDevice(&dev);
        hipDeviceGetAttribute(&cus, hipDeviceAttributeMultiprocessorCount, dev);
        hipFuncSetAttribute((const void*)mega, hipFuncAttributeMaxDynamicSharedMemorySize, LDS_BYTES);
        hipOccupancyMaxActiveBlocksPerMultiprocessor(&per_cu, (const void*)mega, 512, LDS_BYTES);
        if (per_cu < 1) per_cu = 1;
        if (per_cu > 1) per_cu = 1;
        grid_blocks = cus * per_cu;
        if (n_in != 34 || ws_size < WS_END1 || ws_size < WS_END2) fprintf(stderr, "kernel_launch: unexpected n_in %d / ws %zu\n", n_in, ws_size);
    }
    hipMemsetAsync(d_ws, 0, 256, stream);
    Params p{};
    for (int i = 0; i < 34; ++i) p.in[i] = (const float*)d_in[i];
    p.out = (float*)d_out;
    p.ws = (unsigned char*)d_ws;
#if MK_MULTI
    for (int ph = 0; ph < NPH; ++ph) {
        p.ph_lo = ph; p.ph_hi = ph + 1;
        hipLaunchKernelGGL(mega, dim3(grid_blocks), dim3(512), LDS_BYTES, stream, p);
    }
#else
    p.ph_lo = 0; p.ph_hi = NPH;
    void* args[] = {&p};
    hipError_t e = hipLaunchCooperativeKernel((const void*)mega, dim3(grid_blocks), dim3(512), args, LDS_BYTES, stream);
    if (e != hipSuccess) fprintf(stderr, "cooperative launch failed: %s (grid %d)\n", hipGetErrorString(e), grid_blocks);
#endif
}
```

```cpp
#include <hip/hip_runtime.h>
#include <hip/hip_cooperative_groups.h>
#include <cstdio>
#include <cstdint>
namespace cg = cooperative_groups;

#ifndef SKIP_SCAN
#define SKIP_SCAN 0
#endif
#ifndef SKIP_NA
#define SKIP_NA 0
#endif
#ifndef REP_SCAN
#define REP_SCAN 0
#endif
#ifndef REP_MISC
#define REP_MISC 0
#endif
#ifndef REP_NA
#define REP_NA 0
#endif
#ifndef REP_SYNC
#define REP_SYNC 0
#endif
#ifndef KSTAGGER
#define KSTAGGER 1
#endif
#ifndef REP_GEMM
#define REP_GEMM 0
#endif
#ifndef MK_MULTI
#define MK_MULTI 0
#endif

#define DEV __device__ __forceinline__
#define VT ((int)(threadIdx.x & 255))
#define VB ((int)(blockIdx.x * 2 + (threadIdx.x >> 8)))
#define VG ((int)(gridDim.x * 2))

typedef unsigned short bf16_t;
typedef short bf16x8 __attribute__((ext_vector_type(8)));
typedef short bf16x4 __attribute__((ext_vector_type(4)));
typedef float f32x4 __attribute__((ext_vector_type(4)));
typedef float f32x2 __attribute__((ext_vector_type(2)));
typedef unsigned u32x4 __attribute__((ext_vector_type(4)));
typedef unsigned u32x2 __attribute__((ext_vector_type(2)));

constexpr int NT = 49152, NTP = 16384, DM = 1024, ZW = 3456, DFF = 2816;
constexpr int CH = 256, NCHUNK = NT / CH, NSUB = CH / 16;
constexpr int NPH = 13;

constexpr size_t OFF_WIN_T = 4096;
constexpr size_t OFF_WBRA_T = OFF_WIN_T + (size_t)5504 * 1024 * 2;
constexpr size_t OFF_WBRN_T = OFF_WBRA_T + (size_t)1024 * 512 * 2;
constexpr size_t OFF_WOUT_T = OFF_WBRN_T + (size_t)1024 * 512 * 2;
constexpr size_t OFF_WGATE_T = OFF_WOUT_T + (size_t)1024 * 1024 * 2;
constexpr size_t OFF_WUP_T = OFF_WGATE_T + (size_t)2816 * 1024 * 2;
constexpr size_t OFF_WDOWN_T = OFF_WUP_T + (size_t)2816 * 1024 * 2;
constexpr size_t OFF_WPLE_T = OFF_WDOWN_T + (size_t)2816 * 1024 * 2;
constexpr size_t OFF_WPG_T = OFF_WPLE_T + (size_t)1024 * 256 * 2;
constexpr size_t OFF_HMIX = OFF_WPG_T + (size_t)1024 * 1024 * 2;
constexpr size_t OFF_Z = OFF_HMIX + (size_t)NT * 1024 * 2;
constexpr size_t OFF_UA = OFF_Z + (size_t)NT * ZW * 2;
constexpr size_t OFF_LORA = OFF_UA + (size_t)NT * 512 * 2;
constexpr size_t WS_END1 = OFF_LORA + 196608 * 2;
constexpr size_t OFF_RSS = WS_END1;
constexpr size_t WS_END3 = OFF_RSS + (size_t)NT * 4 * 4;
constexpr size_t OFF_X1 = OFF_HMIX;
constexpr size_t OFF_ACT = OFF_X1 + (size_t)NT * 1024 * 4;
constexpr size_t WS_END2 = OFF_ACT + (size_t)NT * DFF * 2;
static_assert(WS_END1 <= 536870912ull && WS_END2 <= 536870912ull && WS_END3 <= 536870912ull, "workspace");
constexpr size_t OUT_PBF = (size_t)NT * 1024 * 2;

constexpr int LDS_BYTES = 131072;

struct Params {
    const float* in[34];
    float* out;
    unsigned char* ws;
    int ph_lo, ph_hi;
};

typedef __bf16 bf16x2n __attribute__((ext_vector_type(2)));
DEV unsigned pk2(float lo, float hi) { const f32x2 v = {lo, hi}; return __builtin_bit_cast(unsigned, __builtin_convertvector(v, bf16x2n)); }
DEV float bf_lo(unsigned u) { return __uint_as_float(u << 16); }
DEV float bf_hi(unsigned u) { return __uint_as_float(u & 0xffff0000u); }
DEV f32x4 ld4bf(const bf16_t* p) { u32x2 u = *(const u32x2*)p; return (f32x4){bf_lo(u.x), bf_hi(u.x), bf_lo(u.y), bf_hi(u.y)}; }
DEV void st4bf(bf16_t* p, f32x4 v) { u32x2 u; u.x = pk2(v[0], v[1]); u.y = pk2(v[2], v[3]); *(u32x2*)p = u; }
DEV float wave_sum(float v) {
#pragma unroll
    for (int o = 32; o > 0; o >>= 1) v += __shfl_xor(v, o);
    return v;
}
DEV float dpp_x1(float v) { return __int_as_float(__builtin_amdgcn_update_dpp(0, __float_as_int(v), 0xB1, 0xF, 0xF, true)); }
DEV float dpp_x2(float v) { return __int_as_float(__builtin_amdgcn_update_dpp(0, __float_as_int(v), 0x4E, 0xF, 0xF, true)); }
DEV float dpp_hm(float v) { return __int_as_float(__builtin_amdgcn_update_dpp(0, __float_as_int(v), 0x141, 0xF, 0xF, true)); }
DEV float dpp_rm(float v) { return __int_as_float(__builtin_amdgcn_update_dpp(0, __float_as_int(v), 0x140, 0xF, 0xF, true)); }
DEV float sum16(float v) { v += dpp_x1(v); v += dpp_x2(v); v += dpp_hm(v); v += dpp_rm(v); return v; }
DEV float sigmoidf_(float x) { return __builtin_amdgcn_rcpf(1.f + __expf(-x)); }
DEV const float* xrow(const Params& p, int t) { return t < NTP ? p.in[0] + (size_t)t * DM : p.in[1] + (size_t)(t - NTP) * DM; }
DEV const float* prow(const Params& p, int t) { return t < NTP ? p.in[2] + (size_t)t * 256 : p.in[3] + (size_t)(t - NTP) * 256; }

template <int rmode = 0>
DEV void transpose_tile(const float* __restrict__ W, int K, int N, bf16_t* __restrict__ Wt, int tile, float* lds) {
    const int ntn = N / 64, kb = tile / ntn, nb = tile % ntn, k0 = kb * 64, n0 = nb * 64, tid = VT;
#pragma unroll
    for (int i = 0; i < 16; ++i) { const int kk = (tid >> 6) + 4 * i; lds[kk * 65 + (tid & 63)] = W[(size_t)(k0 + kk) * N + n0 + (tid & 63)]; }
    __syncthreads();
    const int n = tid >> 2, kq = tid & 3;
    unsigned w[8];
#pragma unroll
    for (int j = 0; j < 8; ++j) w[j] = pk2(lds[(kq * 16 + 2 * j) * 65 + n], lds[(kq * 16 + 2 * j + 1) * 65 + n]);
    const int nsrc = n0 + n, nrow = rmode == 0 ? nsrc : ((nsrc >> 4) * 32 + (nsrc & 15) + (rmode == 2 ? 16 : 0));
    u32x4* dst = (u32x4*)(Wt + (size_t)nrow * K + k0 + kq * 16);
    dst[0] = (u32x4){w[0], w[1], w[2], w[3]};
    dst[1] = (u32x4){w[4], w[5], w[6], w[7]};
    __syncthreads();
}

DEV void norm_row_bf16(const float* __restrict__ src, const float* __restrict__ g, bf16_t* __restrict__ dst, int lane) {
    f32x4 v[4]; float s = 0.f;
#pragma unroll
    for (int j = 0; j < 4; ++j) { v[j] = *(const f32x4*)(src + j * 256 + lane * 4); s += v[j][0] * v[j][0] + v[j][1] * v[j][1] + v[j][2] * v[j][2] + v[j][3] * v[j][3]; }
    s = wave_sum(s);
    const float r = 1.0f / sqrtf(s * (1.f / 1024.f) + 1e-6f);
#pragma unroll
    for (int j = 0; j < 4; ++j) { const f32x4 gg = *(const f32x4*)(g + j * 256 + lane * 4); st4bf(dst + j * 256 + lane * 4, v[j] * r * gg); }
}
DEV void norm_row_f32(const float* __restrict__ src, const float* __restrict__ g, float* __restrict__ dst, int lane) {
    f32x4 v[4]; float s = 0.f;
#pragma unroll
    for (int j = 0; j < 4; ++j) { v[j] = *(const f32x4*)(src + j * 256 + lane * 4); s += v[j][0] * v[j][0] + v[j][1] * v[j][1] + v[j][2] * v[j][2] + v[j][3] * v[j][3]; }
    s = wave_sum(s);
    const float r = 1.0f / sqrtf(s * (1.f / 1024.f) + 1e-6f);
#pragma unroll
    for (int j = 0; j < 4; ++j) { const f32x4 gg = *(const f32x4*)(g + j * 256 + lane * 4); *(f32x4*)(dst + j * 256 + lane * 4) = v[j] * r * gg; }
}

DEV void phase0(const Params& p, unsigned char* ldsb) {
    float* lds = (float*)ldsb;
    constexpr int T0 = 16 * 86, T1 = 8 * 16, T2 = 8 * 16, T3 = 16 * 16, T4 = 16 * 44, T5 = 16 * 44, T6 = 44 * 16, T7 = 4 * 16, T8 = 16 * 16;
    constexpr int NTILES = T0 + T1 + T2 + T3 + T4 + T5 + T6 + T7 + T8 + 48;
    for (int it = VB; it < NTILES; it += VG) {
        int r = it;
        if (r < T0) { transpose_tile(p.in[5], 1024, 5504, (bf16_t*)(p.ws + OFF_WIN_T), r, lds); continue; } r -= T0;
        if (r < T1) { transpose_tile(p.in[23], 512, 1024, (bf16_t*)(p.ws + OFF_WBRA_T), r, lds); continue; } r -= T1;
        if (r < T2) { transpose_tile(p.in[24], 512, 1024, (bf16_t*)(p.ws + OFF_WBRN_T), r, lds); continue; } r -= T2;
        if (r < T3) { transpose_tile(p.in[25], 1024, 1024, (bf16_t*)(p.ws + OFF_WOUT_T), r, lds); continue; } r -= T3;
        if (r < T4) { transpose_tile<1>(p.in[27], 1024, 2816, (bf16_t*)(p.ws + OFF_WGATE_T), r, lds); continue; } r -= T4;
        if (r < T5) { transpose_tile<2>(p.in[28], 1024, 2816, (bf16_t*)(p.ws + OFF_WGATE_T), r, lds); continue; } r -= T5;
        if (r < T6) { transpose_tile(p.in[29], 2816, 1024, (bf16_t*)(p.ws + OFF_WDOWN_T), r, lds); continue; } r -= T6;
        if (r < T7) { transpose_tile(p.in[31], 256, 1024, (bf16_t*)(p.ws + OFF_WPLE_T), r, lds); continue; } r -= T7;
        if (r < T8) { transpose_tile(p.in[32], 1024, 1024, (bf16_t*)(p.ws + OFF_WPG_T), r, lds); continue; } r -= T8;
        bf16_t* lb = (bf16_t*)(p.ws + OFF_LORA);
        if (r < 8) { transpose_tile(p.in[9], 64, 512, lb, r, lds); continue; } r -= 8;
        if (r < 8) { transpose_tile(p.in[11], 64, 512, lb + 32768, r, lds); continue; } r -= 8;
        if (r < 8) { transpose_tile(p.in[13], 64, 512, lb + 65536, r, lds); continue; } r -= 8;
        if (r < 8) { transpose_tile(p.in[15], 64, 512, lb + 98304, r, lds); continue; } r -= 8;
        transpose_tile(p.in[16], 128, 512, lb + 131072, r, lds);
    }
    const int wave = VT >> 6, lane = VT & 63;
    bf16_t* hmix = (bf16_t*)(p.ws + OFF_HMIX);
    for (int t = VB * 4 + wave; t < NT; t += VG * 4) norm_row_bf16(xrow(p, t), p.in[4], hmix + (size_t)t * DM, lane);
}

DEV void gemm_acc(f32x4 (&acc)[4][4], const bf16_t* __restrict__ A, int lda, const bf16_t* __restrict__ Bt, int ldb, int K, unsigned char* lds) {
    const int tid = VT, wid = tid >> 6, lane = tid & 63, wr = wid >> 1, wc = wid & 1, fr = lane & 15, fq = lane >> 4;
    const int lr = tid >> 3, lc = tid & 7;
    const bf16_t* ga = A + (size_t)lr * lda + lc * 8;
    const bf16_t* gb = Bt + (size_t)lr * ldb + lc * 8;
    const size_t sa32 = (size_t)32 * lda, sb32 = (size_t)32 * ldb;
    const int soff = lr * 128 + ((lc ^ (lr & 7)) << 4);
    u32x4 ra[4], rb[4];
    const int nk = K >> 6;
#pragma unroll
    for (int i = 0; i < 4; ++i) { ra[i] = *(const u32x4*)(ga + i * sa32); rb[i] = *(const u32x4*)(gb + i * sb32); }
#pragma unroll
    for (int i = 0; i < 4; ++i) { *(u32x4*)(lds + soff + i * 4096) = ra[i]; *(u32x4*)(lds + 16384 + soff + i * 4096) = rb[i]; }
    __syncthreads();
#pragma unroll 1
    for (int kt = 0; kt < nk; ++kt) {
        const bool more = (kt + 1) < nk;
        if (more) {
#pragma unroll
            for (int i = 0; i < 4; ++i) { ra[i] = *(const u32x4*)(ga + i * sa32 + (kt + 1) * 64); rb[i] = *(const u32x4*)(gb + i * sb32 + (kt + 1) * 64); }
        }
        const unsigned char* sa = lds + (kt & 1) * 32768;
        const unsigned char* sb = sa + 16384;
#pragma unroll
        for (int ks = 0; ks < 2; ++ks) {
            bf16x8 af[4], bfr[4];
            const int ch = ((ks * 4 + fq) ^ (fr & 7)) << 4;
#pragma unroll
            for (int m = 0; m < 4; ++m) af[m] = *(const bf16x8*)(sa + (wr * 64 + m * 16 + fr) * 128 + ch);
#pragma unroll
            for (int n = 0; n < 4; ++n) bfr[n] = *(const bf16x8*)(sb + (wc * 64 + n * 16 + fr) * 128 + ch);
#pragma unroll
            for (int m = 0; m < 4; ++m)
#pragma unroll
                for (int n = 0; n < 4; ++n) acc[m][n] = __builtin_amdgcn_mfma_f32_16x16x32_bf16(bfr[n], af[m], acc[m][n], 0, 0, 0);
        }
        if (more) {
            unsigned char* d = lds + ((kt + 1) & 1) * 32768;
#pragma unroll
            for (int i = 0; i < 4; ++i) { *(u32x4*)(d + soff + i * 4096) = ra[i]; *(u32x4*)(d + 16384 + soff + i * 4096) = rb[i]; }
        }
        __syncthreads();
    }
}
DEV void zero_acc(f32x4 (&acc)[4][4]) {
#pragma unroll
    for (int m = 0; m < 4; ++m)
#pragma unroll
        for (int n = 0; n < 4; ++n) acc[m][n] = (f32x4){0.f, 0.f, 0.f, 0.f};
}

struct TileIter {
    int ntn, per_xcd, i, step, x, rows_x;
    DEV void init(int ntm, int ntn_) {
        ntn = ntn_;
        if ((gridDim.x & 7) == 0 && (ntm & 63) == 0) { x = blockIdx.x & 7; i = (int)(blockIdx.x >> 3) * 2 + (int)(threadIdx.x >> 8); step = (int)(gridDim.x >> 3) * 2; rows_x = ntm >> 3; per_xcd = rows_x * ntn; }
        else { x = -1; i = VB; step = VG; rows_x = ntm; per_xcd = ntm * ntn; }
    }
    DEV bool next(int& tm, int& tn) {
        if (i >= per_xcd) return false;
        if (x >= 0) { const int g = i / (8 * ntn), rem = i - g * 8 * ntn; tn = rem >> 3; tm = x * rows_x + g * 8 + (rem & 7); }
        else { tm = i / ntn; tn = i - tm * ntn; }
        i += step; return true;
    }
};

DEV void gemm256_acc(f32x4 (&acc)[8][4], const bf16_t* __restrict__ A, int lda, const bf16_t* __restrict__ Bt, int ldb, int K, unsigned char* lds) {
    __builtin_amdgcn_sched_barrier(0);
    const int tid = threadIdx.x, wid = tid >> 6, lane = tid & 63, wr = wid >> 2, wc = wid & 3, fr = lane & 15, fq = lane >> 4;
    int ozg; asm volatile("s_mov_b32 %0, 0" : "=s"(ozg));
    const int drow = (lane >> 3) + ozg, dch = (lane & 7) ^ (lane >> 3);
    const bf16_t* ga = A + (size_t)(wid * 32 + drow) * lda + dch * 8;
    const bf16_t* gb = Bt + (size_t)(wid * 32 + drow) * ldb + dch * 8;
    const size_t a8 = (size_t)8 * lda, b8 = (size_t)8 * ldb;
    const int nk = K >> 6;
    int kbase = (int)(KSTAGGER == 1 ? (blockIdx.x & 7) * nk / 8 : (KSTAGGER == 2 ? ((blockIdx.x >> 6) & 3) * nk / 4 : 0));
    asm volatile("s_waitcnt vmcnt(0)" ::: "memory");
#define G256_STAGE(kt_) do { unsigned char* sd_ = lds + ((kt_) & 1) * 65536 + wid * 4096; int kk_ = (kt_) + kbase; if (kk_ >= nk) kk_ -= nk; const int ko_ = kk_ * 64; \
        _Pragma("unroll") for (int i_ = 0; i_ < 4; ++i_) { \
            __builtin_amdgcn_global_load_lds((const unsigned*)(ga + i_ * a8 + ko_), (unsigned*)(sd_ + i_ * 1024), 16, 0, 0); \
            __builtin_amdgcn_global_load_lds((const unsigned*)(gb + i_ * b8 + ko_), (unsigned*)(sd_ + 32768 + i_ * 1024), 16, 0, 0); } } while (0)
    const int ch0 = (fq ^ (fr & 7)) << 4, ch1 = ((4 + fq) ^ (fr & 7)) << 4;
    const int aoff = (wr * 128 + fr) * 128, boff = 32768 + (wc * 64 + fr) * 128;
    bf16x8 bf0[4], bf1[4], afA[4], afB[4];
#define LD_B(dst, ch) _Pragma("unroll") for (int n = 0; n < 4; ++n) dst[n] = *(const bf16x8*)(sb + n * 2048 + (ch))
#define LD_A(dst, mh, ch) _Pragma("unroll") for (int m = 0; m < 4; ++m) dst[m] = *(const bf16x8*)(sa + ((mh) * 4 + m) * 2048 + (ch))
#define MM(af, bf, mh) _Pragma("unroll") for (int m = 0; m < 4; ++m) _Pragma("unroll") for (int n = 0; n < 4; ++n) \
            acc[(mh) * 4 + m][n] = __builtin_amdgcn_mfma_f32_16x16x32_bf16(bf[n], af[m], acc[(mh) * 4 + m][n], 0, 0, 0)
#define SB_ __builtin_amdgcn_sched_barrier(0)
    G256_STAGE(0);
    asm volatile("s_waitcnt vmcnt(0)" ::: "memory");
    __builtin_amdgcn_s_barrier();
    if (nk > 1) G256_STAGE(1);
    {
        const unsigned char* sa = lds + aoff; const unsigned char* sb = lds + boff;
        LD_B(bf0, ch0); LD_A(afA, 0, ch0); SB_;
    }
#pragma unroll 1
    for (int kt = 0; kt < nk; ++kt) {
        const unsigned char* sa = lds + (kt & 1) * 65536 + aoff;
        const unsigned char* sb = lds + (kt & 1) * 65536 + boff;
        LD_A(afB, 1, ch0); SB_;
        MM(afA, bf0, 0); SB_;
        LD_B(bf1, ch1); LD_A(afA, 0, ch1); SB_;
        MM(afB, bf0, 1); SB_;
        LD_A(afB, 1, ch1); SB_;
        MM(afA, bf1, 0); SB_;
        asm volatile("s_waitcnt lgkmcnt(0)" ::: "memory");
        asm volatile("s_waitcnt vmcnt(0)" ::: "memory");
        __builtin_amdgcn_s_barrier();
        SB_;
        if (kt + 2 < nk) G256_STAGE(kt + 2);
        if (kt + 1 < nk) {
            const unsigned char* sa = lds + ((kt + 1) & 1) * 65536 + aoff;
            const unsigned char* sb = lds + ((kt + 1) & 1) * 65536 + boff;
            LD_B(bf0, ch0); LD_A(afA, 0, ch0);
        }
        SB_;
        MM(afB, bf1, 1); SB_;
    }
#undef SB_
#undef LD_B
#undef LD_A
#undef MM
#undef G256_STAGE
}
DEV void zero_acc256(f32x4 (&acc)[8][4]) {
#pragma unroll
    for (int m = 0; m < 8; ++m)
#pragma unroll
        for (int n = 0; n < 4; ++n) acc[m][n] = (f32x4){0.f, 0.f, 0.f, 0.f};
}
struct TileIter256 {
    int ntn, per_xcd, i, step, x, rows_x;
    DEV void init(int ntm, int ntn_) {
        ntn = ntn_;
        if ((gridDim.x & 7) == 0 && (ntm & 63) == 0) { x = blockIdx.x & 7; i = blockIdx.x >> 3; step = gridDim.x >> 3; rows_x = ntm >> 3; per_xcd = rows_x * ntn; }
        else { x = -1; i = blockIdx.x; step = gridDim.x; rows_x = ntm; per_xcd = ntm * ntn; }
    }
    DEV bool next(int& tm, int& tn) {
        if (i >= per_xcd) return false;
        if (x >= 0) { const int g = i / (8 * ntn), rem = i - g * 8 * ntn; tn = rem >> 3; tm = x * rows_x + g * 8 + (rem & 7); }
        else { tm = i / ntn; tn = i - tm * ntn; }
        i += step; return true;
    }
};
#define EPI256_COORDS const int tid_ = threadIdx.x, wid_ = tid_ >> 6, lane_ = tid_ & 63, wr_ = wid_ >> 2, wc_ = wid_ & 3, fr_ = lane_ & 15, fq_ = lane_ >> 4;
#define EPI256_ROW(m) (row0 + wr_ * 128 + (m) * 16 + fr_)
#define EPI256_COL(n) (col0 + wc_ * 64 + (n) * 16 + fq_ * 4)

#define EPI_COORDS const int tid_ = VT, wid_ = tid_ >> 6, lane_ = tid_ & 63, wr_ = wid_ >> 1, wc_ = wid_ & 1, fr_ = lane_ & 15, fq_ = lane_ >> 4;
#define EPI_ROW(m) (row0 + wr_ * 64 + (m) * 16 + fr_)
#define EPI_COL(n) (col0 + wc_ * 64 + (n) * 16 + fq_ * 4)

DEV void phase1(const Params& p, unsigned char* lds_all) {
    const bf16_t* hmix = (const bf16_t*)(p.ws + OFF_HMIX);
    const bf16_t* wt = (const bf16_t*)(p.ws + OFF_WIN_T);
    bf16_t* z = (bf16_t*)(p.ws + OFF_Z);
    constexpr int NTN = (ZW + 255) / 256;
    TileIter256 ti; ti.init(NT / 256, NTN);
    for (int tm_, tn_; ti.next(tm_, tn_);) {
        const int row0 = tm_ * 256, col0 = tn_ * 256;
        f32x4 acc[8][4]; zero_acc256(acc);
        gemm256_acc(acc, hmix + (size_t)row0 * DM, DM, wt + (size_t)col0 * DM, DM, DM, lds_all);
        EPI256_COORDS
        int oz; asm volatile("s_mov_b32 %0, 0" : "=s"(oz));
#pragma unroll
        for (int m = 0; m < 8; ++m)
#pragma unroll
            for (int n = 0; n < 4; ++n) {
                const int rl = wr_ * 128 + m * 16 + fr_ + oz, cl = wc_ * 64 + n * 16 + fq_ * 4;
                u32x2 u; u.x = pk2(acc[m][n][0], acc[m][n][1]); u.y = pk2(acc[m][n][2], acc[m][n][3]);
                *(u32x2*)(lds_all + rl * 512 + (((cl >> 3) ^ (rl & 31)) << 4) + ((cl & 7) << 1)) = u;
            }
        __syncthreads();
#pragma unroll
        for (int k = 0; k < 16; ++k) {
            const int idx = tid_ + 512 * k + oz, rl = idx >> 5, ch = idx & 31;
            const u32x4 v = *(const u32x4*)(lds_all + rl * 512 + ((ch ^ (rl & 31)) << 4));
            const int col = col0 + ch * 8;
            if (col < ZW) *(u32x4*)(z + (size_t)(row0 + rl) * ZW + col) = v;
        }
        __syncthreads();
    }
}

constexpr int L_WD = 0, L_AA = 1024, L_BD = 2048, L_KD = 3072, L_RR = 4096, L_VV = 5120, L_XW = 6144, L_XA = 7168, L_BDOT = 8192  , L_O = 10368, L_LG = 11392;
constexpr int LB_XWB = 49664, LB_XAB = 51968, LB_XGB = 54272;

DEV f32x4 shift4(const bf16_t* __restrict__ z, int t, int col, int sstart, int send, const float* __restrict__ mup, const float* __restrict__ mun) {
    const bf16_t* q = z + (size_t)t * ZW + col;
    const f32x4 c = ld4bf(q);
    f32x4 zp = (f32x4){0.f, 0.f, 0.f, 0.f}, zn = (f32x4){0.f, 0.f, 0.f, 0.f};
    if (t > sstart) zp = ld4bf(q - ZW);
    if (t < send - 1) zn = ld4bf(q + ZW);
    const f32x4 mp = *(const f32x4*)(mup + col), mn = *(const f32x4*)(mun + col);
    return c + mp * (zp - c) + mn * (zn - c);
}

struct Raw3 { u32x2 c, p, n; };
DEV Raw3 shift_load(const bf16_t* __restrict__ z, int t, int col, int sstart, int send) {
    const bf16_t* q = z + (size_t)t * ZW + col;
    Raw3 r; r.c = *(const u32x2*)q; r.p = (u32x2){0u, 0u}; r.n = (u32x2){0u, 0u};
    if (t > sstart) r.p = *(const u32x2*)(q - ZW);
    if (t < send - 1) r.n = *(const u32x2*)(q + ZW);
    return r;
}
DEV f32x4 shift_apply(const Raw3& r, int col, const float* __restrict__ mup, const float* __restrict__ mun) {
    const f32x4 c = (f32x4){bf_lo(r.c.x), bf_hi(r.c.x), bf_lo(r.c.y), bf_hi(r.c.y)};
    const f32x4 zp = (f32x4){bf_lo(r.p.x), bf_hi(r.p.x), bf_lo(r.p.y), bf_hi(r.p.y)};
    const f32x4 zn = (f32x4){bf_lo(r.n.x), bf_hi(r.n.x), bf_lo(r.n.y), bf_hi(r.n.y)};
    const f32x4 mp = *(const f32x4*)(mup + col), mn = *(const f32x4*)(mun + col);
    return c + mp * (zp - c) + mn * (zn - c);
}

struct LoraFrag { bf16x8 w[2], a[2], g[4]; };
template <bool L3, int d>
DEV void lora_load(const Params& p, LoraFrag& lf, int h) {
    const int lane = VT & 63, w = VT >> 6, fr = lane & 15, fq = lane >> 4;
    const int c = h * 64 + w * 16 + fr;
    const bf16_t* base = (const bf16_t*)(p.ws + OFF_LORA);
    const bf16_t* w2t = base + (d ? 32768 : 0) + c * 64 + fq * 8;
    const bf16_t* a2t = base + 65536 + (d ? 32768 : 0) + c * 64 + fq * 8;
#pragma unroll
    for (int ks = 0; ks < 2; ++ks) { lf.w[ks] = *(const bf16x8*)(w2t + ks * 32); lf.a[ks] = *(const bf16x8*)(a2t + ks * 32); }
    if (L3 && d == 1) {
        const bf16_t* g2t = base + 131072 + c * 128 + fq * 8;
#pragma unroll
        for (int ks = 0; ks < 4; ++ks) lf.g[ks] = *(const bf16x8*)(g2t + ks * 32);
    }
}
DEV float tanh_fast(float x) { return 1.f - 2.f * __builtin_amdgcn_rcpf(1.f + __expf(2.f * x)); }

template <bool L3, int d>
DEV void scan_prep(const Params& p, float* lds, const LoraFrag& lf, int ts, int tloc0, int h, int sstart, int send) {
    const bf16_t* z = (const bf16_t*)(p.ws + OFF_Z);
    const float* mup = p.in[6];
    const float* mun = p.in[7];
    const int tid = VT, tt = tid >> 4, q16 = tid & 15, t = ts + tt;
    const int j0 = q16 * 4, c0 = h * 64 + j0;
    bf16_t* xwb = (bf16_t*)((unsigned char*)lds + LB_XWB);
    bf16_t* xab = (bf16_t*)((unsigned char*)lds + LB_XAB);
    bf16_t* xgb = (bf16_t*)((unsigned char*)lds + LB_XGB);
    const f32x4 xw = shift4(z, t, 1536 + d * 64 + j0, sstart, send, mup, mun);
    const f32x4 xa = shift4(z, t, 1664 + d * 64 + j0, sstart, send, mup, mun);
    const Raw3 rr = shift_load(z, t, c0, sstart, send), rk3 = shift_load(z, t, 512 + c0, sstart, send), rv = shift_load(z, t, 1024 + c0, sstart, send);
    st4bf(xwb + tt * 72 + j0, (f32x4){tanh_fast(xw[0]), tanh_fast(xw[1]), tanh_fast(xw[2]), tanh_fast(xw[3])});
    st4bf(xab + tt * 72 + j0, xa);
    if (L3 && d == 1) {
#pragma unroll
        for (int e = 0; e < 2; ++e) {
            const f32x4 xg = shift4(z, t, 1792 + q16 * 8 + e * 4, sstart, send, mup, mun);
            st4bf(xgb + tt * 136 + q16 * 8 + e * 4, (f32x4){sigmoidf_(xg[0]), sigmoidf_(xg[1]), sigmoidf_(xg[2]), sigmoidf_(xg[3])});
        }
    }
    __syncthreads();
    {
        const int lane = tid & 63, w = tid >> 6, fr = lane & 15, fq = lane >> 4;
        f32x4 cw = (f32x4){0.f, 0.f, 0.f, 0.f}, ca = cw;
#pragma unroll
        for (int ks = 0; ks < 2; ++ks) {
            const bf16x8 aw = *(const bf16x8*)(xwb + fr * 72 + ks * 32 + fq * 8);
            const bf16x8 aa = *(const bf16x8*)(xab + fr * 72 + ks * 32 + fq * 8);
            cw = __builtin_amdgcn_mfma_f32_16x16x32_bf16(aw, lf.w[ks], cw, 0, 0, 0);
            ca = __builtin_amdgcn_mfma_f32_16x16x32_bf16(aa, lf.a[ks], ca, 0, 0, 0);
        }
#pragma unroll
        for (int j = 0; j < 4; ++j) { lds[L_XW + (fq * 4 + j) * 64 + w * 16 + fr] = cw[j]; lds[L_XA + (fq * 4 + j) * 64 + w * 16 + fr] = ca[j]; }
        if (L3 && d == 1) {
            f32x4 cg = (f32x4){0.f, 0.f, 0.f, 0.f};
#pragma unroll
            for (int ks = 0; ks < 4; ++ks) {
                const bf16x8 ag = *(const bf16x8*)(xgb + fr * 136 + ks * 32 + fq * 8);
                cg = __builtin_amdgcn_mfma_f32_16x16x32_bf16(ag, lf.g[ks], cg, 0, 0, 0);
            }
#pragma unroll
            for (int j = 0; j < 4; ++j) lds[L_LG + (fq * 4 + j) * 64 + w * 16 + fr] = cg[j];
        }
    }
    __syncthreads();
    const f32x4 r4 = shift_apply(rr, c0, mup, mun), k4 = shift_apply(rk3, 512 + c0, mup, mun), v4 = shift_apply(rv, 1024 + c0, mup, mun);
    const f32x4 lw = *(const f32x4*)(lds + L_XW + tt * 64 + j0), la = *(const f32x4*)(lds + L_XA + tt * 64 + j0);
    const f32x4 w0 = *(const f32x4*)((d ? p.in[10] : p.in[8]) + c0);
    const f32x4 a0 = *(const f32x4*)((d ? p.in[14] : p.in[12]) + c0);
    const f32x4 kkw = *(const f32x4*)(p.in[17] + c0);
    const f32x4 kaw = *(const f32x4*)(p.in[18] + c0);
    f32x4 wd, ar, kk;
    float ss = 0.f;
#pragma unroll
    for (int j = 0; j < 4; ++j) {
        const float x = w0[j] + lw[j];
        const float sp = fmaxf(-x, 0.f) + __logf(1.f + __expf(-fabsf(x)));
        wd[j] = __expf(-__expf(-sp - 0.5f));
        ar[j] = __builtin_amdgcn_rcpf(1.f + __expf(-(a0[j] + la[j])));
        kk[j] = k4[j] * kkw[j];
        ss += kk[j] * kk[j];
    }
    ss = sum16(ss);
    const float inv = 1.f / fmaxf(sqrtf(ss), 1e-12f);
    kk = kk * inv;
    f32x4 kd;
#pragma unroll
    for (int j = 0; j < 4; ++j) kd[j] = k4[j] * (1.f + (ar[j] - 1.f) * kaw[j]);
    *(f32x4*)(lds + L_WD + tt * 64 + j0) = wd;
    *(f32x4*)(lds + L_AA + tt * 64 + j0) = -kk;
    *(f32x4*)(lds + L_BD + tt * 64 + j0) = kk * ar;
    *(f32x4*)(lds + L_KD + tt * 64 + j0) = kd;
    *(f32x4*)(lds + L_RR + tt * 64 + j0) = r4;
    *(f32x4*)(lds + L_VV + tt * 64 + j0) = v4;
    if (L3) {
        const f32x4 rk = *(const f32x4*)(p.in[19] + c0);
        float bd = r4[0] * kd[0] * rk[0] + r4[1] * kd[1] * rk[1] + r4[2] * kd[2] * rk[2] + r4[3] * kd[3] * rk[3];
        bd = sum16(bd);
        if (q16 == 0) lds[L_BDOT + tloc0 + tt] += 0.5f * bd;
    }
    __syncthreads();
}

DEV unsigned prefetch_touch(const bf16_t* z, int ts_next, int h, int d, int sstart, int send) {
    unsigned dummy = 0u;
    const int tid = VT;
    if (tid < 126) {
        const int ti = tid / 7, j = tid - ti * 7;
        int t = ts_next - 1 + ti; t = t < sstart ? sstart : t; t = t > send - 1 ? send - 1 : t;
        const int col = j < 3 ? j * 512 + h * 64 : (j == 3 ? 1536 + d * 64 : (j == 4 ? 1664 + d * 64 : (j == 5 ? 1792 : 1856)));
        const bf16_t* q = z + (size_t)t * ZW + col;
        asm volatile("global_load_dword %0, %1, off" : "=v"(dummy) : "v"(q) : "memory");
    }
    return dummy;
}
DEV void prefetch_retire(unsigned dummy) {
    asm volatile("s_waitcnt vmcnt(0)" ::: "memory");
    asm volatile("" :: "v"(dummy));
}

DEV void seq_bounds(int t0, int& sstart, int& send) {
    if (t0 < NTP) { sstart = 0; send = NTP; }
    else { sstart = NTP + ((t0 - NTP) >> 11) * 2048; send = sstart + 2048; }
}

template <int d>
DEV void l1_body(const Params& p, int item, unsigned char* ldsb) {
    float* lds = (float*)ldsb;
    const int h = item & 7, c = item >> 4, t0 = c * CH;
    int sstart, send; seq_bounds(t0, sstart, send);
    const int tid = VT, rp = tid >> 2, part = tid & 3, cb = part * 16;
    f32x2 Sp[8], Su[8];
    int opq; asm volatile("s_mov_b32 %0, 0" : "=s"(opq));
#pragma unroll
    for (int j = 0; j < 8; ++j) { Sp[j] = (f32x2){(rp + opq == cb + 2 * j) ? 1.f : 0.f, (rp + opq == cb + 2 * j + 1) ? 1.f : 0.f}; Su[j] = (f32x2){0.f, 0.f}; }
    LoraFrag lf; lora_load<false, d>(p, lf, h);
    for (int sci = 0; sci < NSUB; ++sci) {
        const int sc = d ? NSUB - 1 - sci : sci;
        scan_prep<false, d>(p, lds, lf, t0 + sc * 16, sc * 16, h, sstart, send);
        const unsigned pfd = prefetch_touch((const bf16_t*)(p.ws + OFF_Z), t0 + (sci + 1 < NSUB ? (d ? sc - 1 : sc + 1) : sc) * 16, h, d, sstart, send);
        f32x4 an[4]; float vvn;
        {
            const int tf = d ? 15 : 0;
#pragma unroll
            for (int j4 = 0; j4 < 4; ++j4) an[j4] = *(const f32x4*)(lds + L_AA + tf * 64 + cb + j4 * 4);
            vvn = lds[L_VV + tf * 64 + rp];
        }
#pragma unroll 1
        for (int sti = 0; sti < 16; ++sti) {
            const int tl = d ? 15 - sti : sti;
            const int tnx = sti == 15 ? tl : (d ? tl - 1 : tl + 1);
            const float* wp = lds + L_WD + tl * 64 + cb;
            const float* bp = lds + L_BD + tl * 64 + cb;
            const float* kp = lds + L_KD + tl * 64 + cb;
            const float vv = vvn;
            f32x4 ac[4];
#pragma unroll
            for (int j4 = 0; j4 < 4; ++j4) ac[j4] = an[j4];
#pragma unroll
            for (int j4 = 0; j4 < 4; ++j4) an[j4] = *(const f32x4*)(lds + L_AA + tnx * 64 + cb + j4 * 4);
            vvn = lds[L_VV + tnx * 64 + rp];
            f32x2 dp = (f32x2){0.f, 0.f}, du = dp;
#pragma unroll
            for (int j4 = 0; j4 < 4; ++j4) {
                const f32x4 a = ac[j4];
                const f32x2 a0 = (f32x2){a[0], a[1]}, a1 = (f32x2){a[2], a[3]};
                dp += Sp[2 * j4] * a0; du += Su[2 * j4] * a0;
                dp += Sp[2 * j4 + 1] * a1; du += Su[2 * j4 + 1] * a1;
            }
            float sap = dp[0] + dp[1], sau = du[0] + du[1];
            sap += dpp_x1(sap); sau += dpp_x1(sau);
            sap += dpp_x2(sap); sau += dpp_x2(sau);
#pragma unroll
            for (int j4 = 0; j4 < 4; ++j4) {
                const f32x4 w = *(const f32x4*)(wp + j4 * 4), b = *(const f32x4*)(bp + j4 * 4), k = *(const f32x4*)(kp + j4 * 4);
                const f32x2 w0 = (f32x2){w[0], w[1]}, w1 = (f32x2){w[2], w[3]}, b0 = (f32x2){b[0], b[1]}, b1 = (f32x2){b[2], b[3]}, k0 = (f32x2){k[0], k[1]}, k1 = (f32x2){k[2], k[3]};
                Sp[2 * j4] = Sp[2 * j4] * w0 + sap * b0;
                Sp[2 * j4 + 1] = Sp[2 * j4 + 1] * w1 + sap * b1;
                Su[2 * j4] = Su[2 * j4] * w0 + (sau * b0 + vv * k0);
                Su[2 * j4 + 1] = Su[2 * j4 + 1] * w1 + (sau * b1 + vv * k1);
            }
        }
        prefetch_retire(pfd);
        __syncthreads();
    }
    float* Pb = p.out;
    float* Ub = p.out + (size_t)NCHUNK * 16 * 4096;
    const size_t off = ((size_t)((c * 8 + h) * 2 + d)) * 4096 + rp * 64 + cb;
#pragma unroll
    for (int j4 = 0; j4 < 4; ++j4) {
        *(f32x4*)(Pb + off + j4 * 4) = (f32x4){Sp[2 * j4][0], Sp[2 * j4][1], Sp[2 * j4 + 1][0], Sp[2 * j4 + 1][1]};
        *(f32x4*)(Ub + off + j4 * 4) = (f32x4){Su[2 * j4][0], Su[2 * j4][1], Su[2 * j4 + 1][0], Su[2 * j4 + 1][1]};
    }
}
DEV void l1_item(const Params& p, int item, unsigned char* ldsb) { if ((item >> 3) & 1) l1_body<1>(p, item, ldsb); else l1_body<0>(p, item, ldsb); }

DEV void l2_item(const Params& p, int seq, int h, int d, int rb, unsigned char* ldsb) {
    float* srow = (float*)ldsb;
    float* pst = (float*)(ldsb + 2048);
    const float* Pb = p.out;
    float* Ub = p.out + (size_t)NCHUNK * 16 * 4096;
    int cbeg, nc;
    if (seq == 0) { cbeg = 0; nc = NTP / CH; } else { cbeg = NTP / CH + (seq - 1) * (2048 / CH); nc = 2048 / CH; }
    const int tid = VT, row = tid >> 5, cg2 = (tid & 31) * 2, grow = rb * 8 + row;
    const int cstep = d ? -1 : 1, cfirst = d ? cbeg + nc - 1 : cbeg;
    const size_t hd = (size_t)(h * 2 + d) * 4096, cstride = (size_t)16 * 4096;
    float sx = 0.f, sy = 0.f;
    f32x4 pa[4], pb[4];
    f32x2 ucur, unext = (f32x2){0.f, 0.f}, unn = unext;
    {
        const float* src = Pb + (size_t)cfirst * cstride + hd;
#pragma unroll
        for (int i = 0; i < 4; ++i) *(f32x4*)(pst + (tid + 256 * i) * 4) = *(const f32x4*)(src + (tid + 256 * i) * 4);
        ucur = *(const f32x2*)(Ub + (size_t)cfirst * cstride + hd + grow * 64 + cg2);
        if (nc > 1) {
            const size_t b1 = (size_t)(cfirst + cstep) * cstride + hd;
#pragma unroll
            for (int i = 0; i < 4; ++i) pa[i] = *(const f32x4*)(Pb + b1 + (tid + 256 * i) * 4);
            unext = *(const f32x2*)(Ub + b1 + grow * 64 + cg2);
        }
    }
#pragma unroll 1
    for (int ci = 0; ci < nc; ++ci) {
        const int c = cfirst + ci * cstep;
        const size_t base = (size_t)c * cstride + hd;
        if (ci + 2 < nc) {
            const size_t b2 = (size_t)(c + 2 * cstep) * cstride + hd;
#pragma unroll
            for (int i = 0; i < 4; ++i) pb[i] = *(const f32x4*)(Pb + b2 + (tid + 256 * i) * 4);
            unn = *(const f32x2*)(Ub + b2 + grow * 64 + cg2);
        }
        *(f32x2*)(Ub + base + grow * 64 + cg2) = (f32x2){sx, sy};
        *(f32x2*)(srow + row * 64 + cg2) = (f32x2){sx, sy};
        __syncthreads();
        const float* ps = pst + (ci & 1) * 4096 + cg2;
        f32x2 a0 = ucur, a1 = (f32x2){0.f, 0.f}, a2 = a1, a3 = a1;
#pragma unroll 4
        for (int k4 = 0; k4 < 16; ++k4) {
            const f32x4 sv = *(const f32x4*)(srow + row * 64 + k4 * 4);
            a0 += sv[0] * *(const f32x2*)(ps + (k4 * 4 + 0) * 64);
            a1 += sv[1] * *(const f32x2*)(ps + (k4 * 4 + 1) * 64);
            a2 += sv[2] * *(const f32x2*)(ps + (k4 * 4 + 2) * 64);
            a3 += sv[3] * *(const f32x2*)(ps + (k4 * 4 + 3) * 64);
        }
        if (ci + 1 < nc) {
            float* dstp = pst + ((ci + 1) & 1) * 4096;
#pragma unroll
            for (int i = 0; i < 4; ++i) *(f32x4*)(dstp + (tid + 256 * i) * 4) = pa[i];
        }
        __syncthreads();
        sx = (a0[0] + a1[0]) + (a2[0] + a3[0]);
        sy = (a0[1] + a1[1]) + (a2[1] + a3[1]);
        ucur = unext; unext = unn;
#pragma unroll
        for (int i = 0; i < 4; ++i) pa[i] = pb[i];
    }
}

DEV void na_item(const Params& p, int item, unsigned char* ldsb, bool to_ua);
DEV void phase_l2(const Params& p, unsigned char* lds) {
    const int G = VG, b = VB;
    constexpr int N_NA = 768 * 8;
    if (G >= 256) {
        constexpr int N_NA_CHAIN = 1024;
        if (b < 128) {
            if (!SKIP_SCAN) l2_item(p, 0, (b >> 4) & 7, (b >> 3) & 1, b & 7, lds);
            __syncthreads();
            if (!SKIP_NA) for (int it = b; it < N_NA_CHAIN; it += 128) { na_item(p, it, lds, false); __syncthreads(); }
        } else {
            if (!SKIP_SCAN) for (int it = b - 128; it < 2048; it += G - 128) l2_item(p, 1 + (it >> 7), (it >> 4) & 7, (it >> 3) & 1, it & 7, lds);
            __syncthreads();
            if (!SKIP_NA) for (int it = N_NA_CHAIN + b - 128; it < N_NA; it += G - 128) { na_item(p, it, lds, false); __syncthreads(); }
        }
    } else {
        if (!SKIP_SCAN) for (int it = b; it < 2176; it += G) l2_item(p, it >> 7, (it >> 4) & 7, (it >> 3) & 1, it & 7, lds);
        __syncthreads();
        if (!SKIP_NA) for (int it = b; it < N_NA; it += G) { na_item(p, it, lds, false); __syncthreads(); }
    }
}

DEV float reduce8(float v) { v += dpp_x1(v); v += dpp_x2(v); v += dpp_hm(v); return v; }
template <int d>
DEV void l3_pass(const Params& p, float* lds, int h, int c, int t0, int sstart, int send) {
    const int tid = VT, rp = tid >> 3, part = tid & 7, cb = part * 8;
    const float* Sb = p.out + (size_t)NCHUNK * 16 * 4096;
    float* yfg = p.out + (size_t)NT * 512;
    bf16_t* ua = (bf16_t*)(p.ws + OFF_UA);
    LoraFrag lf; lora_load<true, d>(p, lf, h);
    {
        f32x2 S0[4], S1[4];
        {
            const float* src = Sb + ((size_t)((c * 8 + h) * 2 + d)) * 4096 + rp * 64 + cb;
#pragma unroll
            for (int j4 = 0; j4 < 2; ++j4) {
                const f32x4 v = *(const f32x4*)(src + j4 * 4), u = *(const f32x4*)(src + 32 * 64 + j4 * 4);
                S0[2 * j4] = (f32x2){v[0], v[1]}; S0[2 * j4 + 1] = (f32x2){v[2], v[3]};
                S1[2 * j4] = (f32x2){u[0], u[1]}; S1[2 * j4 + 1] = (f32x2){u[2], u[3]};
            }
        }
#pragma unroll 1
        for (int sci = 0; sci < NSUB; ++sci) {
            const int sc = d ? NSUB - 1 - sci : sci;
            scan_prep<true, d>(p, lds, lf, t0 + sc * 16, sc * 16, h, sstart, send);
            const unsigned pfd = prefetch_touch((const bf16_t*)(p.ws + OFF_Z), t0 + (sci + 1 < NSUB ? (d ? sc - 1 : sc + 1) : sc) * 16, h, d, sstart, send);
#pragma unroll 1
            for (int sti = 0; sti < 16; ++sti) {
                const int tl = d ? 15 - sti : sti;
                const float* ap = lds + L_AA + tl * 64 + cb;
                const float* wp = lds + L_WD + tl * 64 + cb;
                const float* bp = lds + L_BD + tl * 64 + cb;
                const float* kp = lds + L_KD + tl * 64 + cb;
                const float* rq = lds + L_RR + tl * 64 + cb;
                f32x2 da0 = (f32x2){0.f, 0.f}, da1 = da0, dy0 = da0, dy1 = da0;
#pragma unroll
                for (int j4 = 0; j4 < 2; ++j4) {
                    const f32x4 a = *(const f32x4*)(ap + j4 * 4);
                    const f32x2 a0 = (f32x2){a[0], a[1]}, a1 = (f32x2){a[2], a[3]};
                    da0 += S0[2 * j4] * a0; da1 += S1[2 * j4] * a0; da0 += S0[2 * j4 + 1] * a1; da1 += S1[2 * j4 + 1] * a1;
                    if (d) {
                        const f32x4 r = *(const f32x4*)(rq + j4 * 4);
                        const f32x2 r0 = (f32x2){r[0], r[1]}, r1 = (f32x2){r[2], r[3]};
                        dy0 += S0[2 * j4] * r0; dy1 += S1[2 * j4] * r0; dy0 += S0[2 * j4 + 1] * r1; dy1 += S1[2 * j4 + 1] * r1;
                    }
                }
                const float sa0 = reduce8(da0[0] + da0[1]), sa1 = reduce8(da1[0] + da1[1]);
                const float vv0 = lds[L_VV + tl * 64 + rp], vv1 = lds[L_VV + tl * 64 + rp + 32];
#pragma unroll
                for (int j4 = 0; j4 < 2; ++j4) {
                    const f32x4 w = *(const f32x4*)(wp + j4 * 4), b = *(const f32x4*)(bp + j4 * 4), k = *(const f32x4*)(kp + j4 * 4);
                    const f32x2 w0 = (f32x2){w[0], w[1]}, w1 = (f32x2){w[2], w[3]}, b0 = (f32x2){b[0], b[1]}, b1 = (f32x2){b[2], b[3]}, k0 = (f32x2){k[0], k[1]}, k1 = (f32x2){k[2], k[3]};
                    const f32x2 s00 = S0[2 * j4] * w0 + (sa0 * b0 + vv0 * k0), s01 = S0[2 * j4 + 1] * w1 + (sa0 * b1 + vv0 * k1);
                    const f32x2 s10 = S1[2 * j4] * w0 + (sa1 * b0 + vv1 * k0), s11 = S1[2 * j4 + 1] * w1 + (sa1 * b1 + vv1 * k1);
                    S0[2 * j4] = s00; S0[2 * j4 + 1] = s01; S1[2 * j4] = s10; S1[2 * j4 + 1] = s11;
                    if (!d) {
                        const f32x4 r = *(const f32x4*)(rq + j4 * 4);
                        const f32x2 r0 = (f32x2){r[0], r[1]}, r1 = (f32x2){r[2], r[3]};
                        dy0 += s00 * r0; dy0 += s01 * r1; dy1 += s10 * r0; dy1 += s11 * r1;
                    }
                }
                const float y0 = reduce8(dy0[0] + dy0[1]), y1 = reduce8(dy1[0] + dy1[1]);
                if (part == 0) {
                    if (d) { lds[L_O + tl * 64 + rp] = y0; lds[L_O + tl * 64 + rp + 32] = y1; }
                    else { float* yq = yfg + (size_t)(t0 + sc * 16 + tl) * 512 + h * 64 + rp; yq[0] = y0; yq[32] = y1; }
                }
            }
            prefetch_retire(pfd);
            __syncthreads();
            if (d == 1) {
                const int tt = tid >> 4, q16 = tid & 15, j0 = q16 * 4, c0 = h * 64 + j0, tloc = sc * 16 + tt;
                const f32x4 ov = *(const f32x4*)(lds + L_O + tt * 64 + j0) + *(const f32x4*)(yfg + (size_t)(t0 + tloc) * 512 + c0);
                const float mean = sum16(ov[0] + ov[1] + ov[2] + ov[3]) * (1.f / 64.f);
                const f32x4 dv = ov - mean;
                const float var = sum16(dv[0] * dv[0] + dv[1] * dv[1] + dv[2] * dv[2] + dv[3] * dv[3]) * (1.f / 64.f);
                const float rstd = 1.0f / sqrtf(var + 64e-5f);
                const f32x4 lw = *(const f32x4*)(p.in[20] + c0), lb = *(const f32x4*)(p.in[21] + c0);
                const float bdot = lds[L_BDOT + tloc];
                const f32x4 v4 = *(const f32x4*)(lds + L_VV + tt * 64 + j0);
                const f32x4 g = *(const f32x4*)(lds + L_LG + tt * 64 + j0);
                const f32x4 res = (dv * rstd * lw + lb + bdot * v4) * g;
                st4bf(ua + (size_t)(t0 + tloc) * 512 + c0, res);
                __syncthreads();
            }
        }
    }
}

DEV void l3_item(const Params& p, int item, unsigned char* ldsb) {
    float* lds = (float*)ldsb;
    const int h = item & 7, c = item >> 3, t0 = c * CH;
    int sstart, send; seq_bounds(t0, sstart, send);
    if (VT < CH) lds[L_BDOT + VT] = 0.f;
    l3_pass<0>(p, lds, h, c, t0, sstart, send);
    l3_pass<1>(p, lds, h, c, t0, sstart, send);
}

DEV void na_item(const Params& p, int item, unsigned char* ldsb, bool to_ua) {
    const int h = item & 7, grow = item >> 3;
    int tok0, rows, r;
    if (grow < 256) { tok0 = 0; rows = 256; r = grow; } else { const int g = grow - 256; tok0 = NTP + (g >> 5) * 2048; rows = 32; r = g & 31; }
    int rs = r - 4; rs = rs < 0 ? 0 : rs; rs = rs > rows - 8 ? rows - 8 : rs;
    bf16_t* z = (bf16_t*)(p.ws + OFF_Z);
    float* rpb_l = (float*)ldsb;
    bf16_t* vt = (bf16_t*)(ldsb + 2048);
    const float* rpb = p.in[22] + h * 465;
    const int tid = VT, w = tid >> 6, lane = tid & 63, fr = lane & 15, fq = lane >> 4;
    for (int i = tid; i < 465; i += 256) rpb_l[i] = rpb[i];
    const int qtok = tok0 + r * 64 + w * 16 + fr;
    bf16x8 qf[2];
#pragma unroll
    for (int ks = 0; ks < 2; ++ks) qf[ks] = *(const bf16x8*)(z + (size_t)qtok * ZW + 1920 + h * 64 + ks * 32 + fq * 8);
    const int kb0 = (w < 2) ? 0 : 1;
    f32x4 sc[8][3];
#pragma unroll
    for (int i = 0; i < 8; ++i)
#pragma unroll
        for (int kb = 0; kb < 3; ++kb) {
            const int ktok = tok0 + (rs + i) * 64 + (kb0 + kb) * 16 + fr;
            f32x4 acc = (f32x4){0.f, 0.f, 0.f, 0.f};
#pragma unroll
            for (int ks = 0; ks < 2; ++ks) {
                const bf16x8 kf = *(const bf16x8*)(z + (size_t)ktok * ZW + 2432 + h * 64 + ks * 32 + fq * 8);
                acc = __builtin_amdgcn_mfma_f32_16x16x32_bf16(kf, qf[ks], acc, 0, 0, 0);
            }
            sc[i][kb] = acc;
        }
    const int kp = tid & 31, dg = tid >> 5;
    __syncthreads();
    u32x4 vr[3][2];
    const bf16_t* vbase = z + (size_t)(tok0 + rs * 64 + 2 * kp) * ZW + 2944 + h * 64 + dg * 8;
#pragma unroll
    for (int i = 0; i < 3; ++i) { vr[i][0] = *(const u32x4*)(vbase + (size_t)i * 64 * ZW); vr[i][1] = *(const u32x4*)(vbase + (size_t)i * 64 * ZW + ZW); }
    const int qc = w * 16 + fr;
    int cs = qc - 8; cs = cs < 0 ? 0 : cs; cs = cs > 48 ? 48 : cs;
    float mx = -1e30f;
#pragma unroll
    for (int i = 0; i < 8; ++i)
#pragma unroll
        for (int kb = 0; kb < 3; ++kb)
#pragma unroll
            for (int j = 0; j < 4; ++j) {
                const int kc = (kb0 + kb) * 16 + fq * 4 + j;
                const bool valid = (kc >= cs) && (kc < cs + 16);
                const int dr = rs + i - r + 7, dc = kc - qc + 15;
                const float s = valid ? sc[i][kb][j] * 0.125f + rpb_l[dr * 31 + (valid ? dc : 0)] : -1e30f;
                sc[i][kb][j] = s;
                mx = fmaxf(mx, s);
            }
    mx = fmaxf(mx, __shfl_xor(mx, 16)); mx = fmaxf(mx, __shfl_xor(mx, 32));
    float sum = 0.f;
#pragma unroll
    for (int i = 0; i < 8; ++i)
#pragma unroll
        for (int kb = 0; kb < 3; ++kb)
#pragma unroll
            for (int j = 0; j < 4; ++j) { const float e = __expf(sc[i][kb][j] - mx); sc[i][kb][j] = e; sum += e; }
    sum += __shfl_xor(sum, 16); sum += __shfl_xor(sum, 32);
    const float inv = 1.f / sum;
    f32x4 oacc[4];
#pragma unroll
    for (int dt = 0; dt < 4; ++dt) oacc[dt] = (f32x4){0.f, 0.f, 0.f, 0.f};
#pragma unroll
    for (int i = 0; i < 8; ++i) {
        unsigned* vts = (unsigned*)(vt + (i & 1) * (64 * 72));
#pragma unroll
        for (int e = 0; e < 4; ++e) {
            const unsigned a = vr[i % 3][0][e], b2 = vr[i % 3][1][e];
            vts[((dg * 8 + 2 * e) * 72 + 2 * kp) >> 1] = (a & 0xffffu) | (b2 << 16);
            vts[((dg * 8 + 2 * e + 1) * 72 + 2 * kp) >> 1] = (a >> 16) | (b2 & 0xffff0000u);
        }
        if (i + 3 < 8) { vr[i % 3][0] = *(const u32x4*)(vbase + (size_t)(i + 3) * 64 * ZW); vr[i % 3][1] = *(const u32x4*)(vbase + (size_t)(i + 3) * 64 * ZW + ZW); }
        __syncthreads();
        const bf16_t* vtr = vt + (i & 1) * (64 * 72);
#pragma unroll
        for (int kb = 0; kb < 3; ++kb) {
            u32x2 pu; pu.x = pk2(sc[i][kb][0], sc[i][kb][1]); pu.y = pk2(sc[i][kb][2], sc[i][kb][3]);
            const bf16x4 pb = __builtin_bit_cast(bf16x4, pu);
#pragma unroll
            for (int dt = 0; dt < 4; ++dt) {
                const bf16x4 a = *(const bf16x4*)(vtr + (dt * 16 + fr) * 72 + (kb0 + kb) * 16 + fq * 4);
                oacc[dt] = __builtin_amdgcn_mfma_f32_16x16x16bf16_1k(a, pb, oacc[dt], 0, 0, 0);
            }
        }
    }
    __syncthreads();
    bf16_t* dstp = to_ua ? (bf16_t*)(p.ws + OFF_UA) + (size_t)qtok * 512 + h * 64 : z + (size_t)qtok * ZW + 1920 + h * 64;
#pragma unroll
    for (int dt = 0; dt < 4; ++dt) st4bf(dstp + dt * 16 + fq * 4, oacc[dt] * inv);
}

DEV void phase2(const Params& p, unsigned char* lds) {
    constexpr int N_L1 = NCHUNK * 16;
    for (int it = VB; it < N_L1; it += VG) {
        if (!SKIP_SCAN) { l1_item(p, it, lds); if (REP_SCAN) { __syncthreads(); l1_item(p, it, lds); } }
        __syncthreads();
    }
}
DEV void phase4(const Params& p, unsigned char* lds) {
    for (int it = VB; it < NCHUNK * 8; it += VG) { l3_item(p, it, lds); __syncthreads(); if (REP_SCAN) { l3_item(p, it, lds); __syncthreads(); } }
}

DEV void tile256_put(unsigned char* lds, int rl, int cl, u32x2 u) { *(u32x2*)(lds + rl * 512 + (((cl >> 3) ^ (rl & 31)) << 4) + ((cl & 7) << 1)) = u; }
DEV void tile256_flush(unsigned char* lds, bf16_t* dst, int ld, int row0, int col0, int oz) {
    __syncthreads();
#pragma unroll
    for (int k = 0; k < 16; ++k) {
        const int idx = (int)threadIdx.x + 512 * k + oz, rl = idx >> 5, ch = idx & 31;
        const u32x4 v = *(const u32x4*)(lds + rl * 512 + ((ch ^ (rl & 31)) << 4));
        *(u32x4*)(dst + (size_t)(row0 + rl) * ld + col0 + ch * 8) = v;
    }
    __syncthreads();
}

template <bool ADD>
DEV void tile256_gate_bf16(unsigned char* lds, const bf16_t* gate, const bf16_t* addend, bf16_t* dst, int ld, const f32x4 (&acc)[8][4], int oz) {
    const int tid = threadIdx.x, wid = tid >> 6, lane = tid & 63, wr = wid >> 2, wc = wid & 3, fr = lane & 15, fq = lane >> 4;
#pragma unroll
    for (int half = 0; half < 2; ++half) {
        asm volatile("s_waitcnt vmcnt(0)" ::: "memory");
#pragma unroll 2
        for (int i = 0; i < 8; ++i) {
            const int r0 = wid * 16 + 2 * i + oz, rl = r0 + (lane >> 5);
            const size_t go = (size_t)(half * 128 + rl) * ld + (((lane & 31) ^ (rl & 31)) << 3);
            __builtin_amdgcn_global_load_lds((const unsigned*)(gate + go), (unsigned*)(lds + r0 * 512), 16, 0, 0);
            if (ADD) __builtin_amdgcn_global_load_lds((const unsigned*)(addend + go), (unsigned*)(lds + 65536 + r0 * 512), 16, 0, 0);
        }
        asm volatile("s_waitcnt vmcnt(0)" ::: "memory");
        __syncthreads();
        if (wr == half) {
#pragma unroll
            for (int m = 0; m < 8; ++m)
#pragma unroll
                for (int n = 0; n < 4; ++n) {
                    const int rl = m * 16 + fr + oz, cl = wc * 64 + n * 16 + fq * 4;
                    unsigned char* q = lds + rl * 512 + (((cl >> 3) ^ (rl & 31)) << 4) + ((cl & 7) << 1);
                    const u32x2 gu = *(const u32x2*)q;
                    f32x4 v = (f32x4){bf_lo(gu.x), bf_hi(gu.x), bf_lo(gu.y), bf_hi(gu.y)} * acc[m][n];
                    if (ADD) { const u32x2 mu = *(const u32x2*)(q + 65536); v += (f32x4){bf_lo(mu.x), bf_hi(mu.x), bf_lo(mu.y), bf_hi(mu.y)}; }
                    u32x2 o; o.x = pk2(v[0], v[1]); o.y = pk2(v[2], v[3]);
                    *(u32x2*)q = o;
                }
        }
        __syncthreads();
#pragma unroll 4
        for (int k = 0; k < 8; ++k) {
            const int idx = tid + 512 * k + oz, rl = idx >> 5, ch = idx & 31;
            const u32x4 v = *(const u32x4*)(lds + rl * 512 + ((ch ^ (rl & 31)) << 4));
            *(u32x4*)(dst + (size_t)(half * 128 + rl) * ld + ch * 8) = v;
        }
        __syncthreads();
    }
}

DEV void phase5(const Params& p, unsigned char* lds_all) {
    const bf16_t* hmix = (const bf16_t*)(p.ws + OFF_HMIX);
    const bf16_t* wt = (const bf16_t*)(p.ws + OFF_WIN_T);
    const bf16_t* wa = (const bf16_t*)(p.ws + OFF_WBRA_T);
    const bf16_t* wn = (const bf16_t*)(p.ws + OFF_WBRN_T);
    const bf16_t* ua = (const bf16_t*)(p.ws + OFF_UA);
    const bf16_t* z = (const bf16_t*)(p.ws + OFF_Z);
    bf16_t* mb = (bf16_t*)p.out;
    bf16_t* tb = (bf16_t*)((unsigned char*)p.out + OUT_PBF);
    TileIter256 ti; ti.init(NT / 256, 4);
    for (int tm_, tn_; ti.next(tm_, tn_);) {
        const int row0 = tm_ * 256, col0 = tn_ * 256;
        EPI256_COORDS
        f32x4 acc[8][4];
        zero_acc256(acc); gemm256_acc(acc, hmix + (size_t)row0 * DM, DM, wt + (size_t)(ZW + col0) * DM, DM, DM, lds_all);
        int oz1; asm volatile("s_mov_b32 %0, 0" : "=s"(oz1));
#pragma unroll
        for (int m = 0; m < 8; ++m)
#pragma unroll
            for (int n = 0; n < 4; ++n) {
                f32x4 v;
#pragma unroll
                for (int j = 0; j < 4; ++j) v[j] = sigmoidf_(acc[m][n][j]);
                u32x2 u; u.x = pk2(v[0], v[1]); u.y = pk2(v[2], v[3]);
                tile256_put(lds_all, wr_ * 128 + m * 16 + fr_ + oz1, wc_ * 64 + n * 16 + fq_ * 4, u);
            }
        tile256_flush(lds_all, mb, DM, row0, col0, oz1);
        zero_acc256(acc); gemm256_acc(acc, ua + (size_t)row0 * 512, 512, wa + (size_t)col0 * 512, 512, 512, lds_all);
        int oz2; asm volatile("s_mov_b32 %0, 0" : "=s"(oz2));
        { bf16_t* mt = mb + (size_t)row0 * DM + col0; tile256_gate_bf16<false>(lds_all, mt, mt, mt, DM, acc, oz2); }
        zero_acc256(acc); gemm256_acc(acc, hmix + (size_t)row0 * DM, DM, wt + (size_t)(ZW + 1024 + col0) * DM, DM, DM, lds_all);
        int oz3; asm volatile("s_mov_b32 %0, 0" : "=s"(oz3));
#pragma unroll
        for (int m = 0; m < 8; ++m)
#pragma unroll
            for (int n = 0; n < 4; ++n) {
                f32x4 v;
#pragma unroll
                for (int j = 0; j < 4; ++j) v[j] = sigmoidf_(acc[m][n][j]);
                u32x2 u; u.x = pk2(v[0], v[1]); u.y = pk2(v[2], v[3]);
                tile256_put(lds_all, wr_ * 128 + m * 16 + fr_ + oz3, wc_ * 64 + n * 16 + fq_ * 4, u);
            }
        tile256_flush(lds_all, tb, DM, row0, col0, oz3);
        zero_acc256(acc); gemm256_acc(acc, z + (size_t)row0 * ZW + 1920, ZW, wn + (size_t)col0 * 512, 512, 512, lds_all);
        int oz4; asm volatile("s_mov_b32 %0, 0" : "=s"(oz4));
        { bf16_t* mt = mb + (size_t)row0 * DM + col0; tile256_gate_bf16<true>(lds_all, tb + (size_t)row0 * DM + col0, mt, mt, DM, acc, oz4); }
    }
}

template <bool NORM = false>
DEV void tile256_resid_f32(unsigned char* lds, const float* src, float* dst, const f32x4 (&acc)[8][4], int oz,
                           bf16_t* hu = nullptr, const float* gain = nullptr, float* rss = nullptr) {
    const int tid = threadIdx.x, wid = tid >> 6, lane = tid & 63, wr = wid >> 2, wc = wid & 3, fr = lane & 15, fq = lane >> 4;
#pragma unroll
    for (int half = 0; half < 2; ++half) {
        asm volatile("s_waitcnt vmcnt(0)" ::: "memory");
#pragma unroll 2
        for (int i = 0; i < 16; ++i) {
            const int rl = wid * 16 + i + oz;
            const float* g = src + (size_t)(half * 128 + rl) * DM + ((lane ^ (rl & 63)) << 2);
            __builtin_amdgcn_global_load_lds((const unsigned*)g, (unsigned*)(lds + rl * 1024), 16, 0, 0);
        }
        asm volatile("s_waitcnt vmcnt(0)" ::: "memory");
        __syncthreads();
        if (wr == half) {
#pragma unroll
            for (int m = 0; m < 8; ++m)
#pragma unroll
                for (int n = 0; n < 4; ++n) {
                    const int rl = m * 16 + fr + oz, ch = (wc * 64 + n * 16 + fq * 4) >> 2;
                    f32x4* q = (f32x4*)(lds + rl * 1024 + ((ch ^ (rl & 63)) << 4));
                    *q = *q + acc[m][n];
                }
        }
        __syncthreads();
        f32x4 g4 = (f32x4){0.f, 0.f, 0.f, 0.f};
        if (NORM) g4 = *(const f32x4*)(gain + lane * 4);
#pragma unroll 4
        for (int k = 0; k < 16; ++k) {
            const int idx = tid + 512 * k + oz, rl = idx >> 6, ch = idx & 63;
            const f32x4 v = *(const f32x4*)(lds + rl * 1024 + ((ch ^ (rl & 63)) << 4));
            *(f32x4*)(dst + (size_t)(half * 128 + rl) * DM + ch * 4) = v;
            if (NORM) {
                st4bf(hu + (size_t)(half * 128 + rl) * DM + ch * 4, v * g4);
                const float ss = wave_sum((v[0] * v[0] + v[1] * v[1]) + (v[2] * v[2] + v[3] * v[3]));
                if (lane == 0) rss[(size_t)(half * 128 + rl) * 4] = ss;
            }
        }
        __syncthreads();
    }
}

DEV void phase6(const Params& p, unsigned char* lds_all) {
    const bf16_t* mb = (const bf16_t*)p.out;
    const bf16_t* wo = (const bf16_t*)(p.ws + OFF_WOUT_T);
    float* x1 = (float*)(p.ws + OFF_X1);
    TileIter256 ti; ti.init(NT / 256, 4);
    for (int tm_, tn_; ti.next(tm_, tn_);) {
        const int row0 = tm_ * 256, col0 = tn_ * 256;
        f32x4 acc[8][4]; zero_acc256(acc);
        gemm256_acc(acc, mb + (size_t)row0 * DM, DM, wo + (size_t)col0 * DM, DM, DM, lds_all);
        int oz; asm volatile("s_mov_b32 %0, 0" : "=s"(oz));
        tile256_resid_f32(lds_all, xrow(p, row0) + col0, x1 + (size_t)row0 * DM + col0, acc, oz);
    }
}

DEV void phase_norm(const Params& p, const float* g, bool with_p) {
    const float* x1 = (const float*)(p.ws + OFF_X1);
    bf16_t* hb = (bf16_t*)p.out;
    const int wave = VT >> 6, lane = VT & 63;
    for (int t = VB * 4 + wave; t < NT; t += VG * 4) {
        norm_row_bf16(x1 + (size_t)t * DM, g, hb + (size_t)t * DM, lane);
        if (with_p) {
            bf16_t* pb = (bf16_t*)((unsigned char*)p.out + OUT_PBF);
            const f32x4 v = *(const f32x4*)(prow(p, t) + lane * 4);
            st4bf(pb + (size_t)t * 256 + lane * 4, v);
        }
    }
}

DEV void phase8(const Params& p, unsigned char* lds_all) {
    const bf16_t* h2 = (const bf16_t*)p.out;
    const bf16_t* wgu = (const bf16_t*)(p.ws + OFF_WGATE_T);
    bf16_t* act = (bf16_t*)(p.ws + OFF_ACT);
    TileIter256 ti; ti.init(NT / 256, 2 * DFF / 256);
    for (int tm_, tn_; ti.next(tm_, tn_);) {
        const int row0 = tm_ * 256, col0 = tn_ * 256;
        f32x4 acc[8][4]; zero_acc256(acc);
        gemm256_acc(acc, h2 + (size_t)row0 * DM, DM, wgu + (size_t)col0 * DM, DM, DM, lds_all);
        EPI256_COORDS
        int oz; asm volatile("s_mov_b32 %0, 0" : "=s"(oz));
#pragma unroll
        for (int m = 0; m < 8; ++m)
#pragma unroll
            for (int q = 0; q < 2; ++q) {
                f32x4 v;
#pragma unroll
                for (int j = 0; j < 4; ++j) { const float gq = acc[m][2 * q][j]; v[j] = gq * sigmoidf_(gq) * acc[m][2 * q + 1][j]; }
                const int rl = wr_ * 128 + m * 16 + fr_ + oz, cl = wc_ * 32 + q * 16 + fq_ * 4;
                u32x2 u; u.x = pk2(v[0], v[1]); u.y = pk2(v[2], v[3]);
                *(u32x2*)(lds_all + rl * 256 + (((cl >> 3) ^ (rl & 15)) << 4) + ((cl & 7) << 1)) = u;
            }
        __syncthreads();
#pragma unroll
        for (int k = 0; k < 8; ++k) {
            const int idx = tid_ + 512 * k + oz, rl = idx >> 4, ch = idx & 15;
            const u32x4 v = *(const u32x4*)(lds_all + rl * 256 + ((ch ^ (rl & 15)) << 4));
            *(u32x4*)(act + (size_t)(row0 + rl) * DFF + tn_ * 128 + ch * 8) = v;
        }
        __syncthreads();
    }
}

DEV void phase9(const Params& p, unsigned char* lds_all) {
    const bf16_t* act = (const bf16_t*)(p.ws + OFF_ACT);
    const bf16_t* wd = (const bf16_t*)(p.ws + OFF_WDOWN_T);
    float* x1 = (float*)(p.ws + OFF_X1);
    TileIter256 ti; ti.init(NT / 256, 4);
    for (int tm_, tn_; ti.next(tm_, tn_);) {
        const int row0 = tm_ * 256, col0 = tn_ * 256;
        f32x4 acc[8][4]; zero_acc256(acc);
        gemm256_acc(acc, act + (size_t)row0 * DFF, DFF, wd + (size_t)col0 * DFF, DFF, DFF, lds_all);
        int oz; asm volatile("s_mov_b32 %0, 0" : "=s"(oz));
        float* xt = x1 + (size_t)row0 * DM + col0;
        tile256_resid_f32<true>(lds_all, xt, xt, acc, oz, (bf16_t*)p.out + (size_t)row0 * DM + col0, p.in[30] + col0,
                                (float*)(p.ws + OFF_RSS) + (size_t)row0 * 4 + tn_);
    }
}

DEV void phase11(const Params& p, unsigned char* lds_all) {
    const bf16_t* h3 = (const bf16_t*)p.out;
    const bf16_t* pb = (const bf16_t*)((const unsigned char*)p.out + OUT_PBF);
    const bf16_t* wp = (const bf16_t*)(p.ws + OFF_WPLE_T);
    const bf16_t* wg = (const bf16_t*)(p.ws + OFF_WPG_T);
    bf16_t* tb = (bf16_t*)(p.ws + OFF_ACT);
    float* x1 = (float*)(p.ws + OFF_X1);
    TileIter256 ti; ti.init(NT / 256, 4);
    for (int tm_, tn_; ti.next(tm_, tn_);) {
        const int row0 = tm_ * 256, col0 = tn_ * 256;
        EPI256_COORDS
        f32x4 acc[8][4];
        zero_acc256(acc); gemm256_acc(acc, h3 + (size_t)row0 * DM, DM, wg + (size_t)col0 * DM, DM, DM, lds_all);
        int oz1; asm volatile("s_mov_b32 %0, 0" : "=s"(oz1));
#pragma unroll
        for (int m = 0; m < 8; ++m) {
            const f32x4 sq = *(const f32x4*)((const float*)(p.ws + OFF_RSS) + (size_t)(EPI256_ROW(m) + oz1) * 4);
            const float rs = 1.0f / sqrtf(((sq[0] + sq[1]) + (sq[2] + sq[3])) * (1.f / 1024.f) + 1e-6f);
#pragma unroll
            for (int n = 0; n < 4; ++n) {
                f32x4 v;
#pragma unroll
                for (int j = 0; j < 4; ++j) v[j] = sigmoidf_(acc[m][n][j] * rs);
                u32x2 u; u.x = pk2(v[0], v[1]); u.y = pk2(v[2], v[3]);
                tile256_put(lds_all, wr_ * 128 + m * 16 + fr_ + oz1, wc_ * 64 + n * 16 + fq_ * 4, u);
            }
        }
        tile256_flush(lds_all, tb, DM, row0, col0, oz1);
        zero_acc256(acc); gemm256_acc(acc, pb + (size_t)row0 * 256, 256, wp + (size_t)col0 * 256, 256, 256, lds_all);
        int oz2; asm volatile("s_mov_b32 %0, 0" : "=s"(oz2));
        const float* __restrict__ xin = x1; float* __restrict__ xo = x1;
        __builtin_amdgcn_sched_barrier(0);
#pragma unroll
        for (int m = 0; m < 8; ++m) {
            __builtin_amdgcn_sched_barrier(0);
            const size_t ro = (size_t)(EPI256_ROW(m) + oz2) * DM;
            f32x4 t[4], g[4];
#pragma unroll
            for (int n = 0; n < 4; ++n) { t[n] = *(const f32x4*)(xin + ro + EPI256_COL(n)); g[n] = ld4bf(tb + ro + EPI256_COL(n)); }
#pragma unroll
            for (int n = 0; n < 4; ++n) *(f32x4*)(xo + ro + EPI256_COL(n)) = t[n] + acc[m][n] * g[n];
        }
    }
}

DEV void phase12(const Params& p) {
    const float* x1 = (const float*)(p.ws + OFF_X1);
    const int wave = VT >> 6, lane = VT & 63;
    for (int t = VB * 4 + wave; t < NT; t += VG * 4) norm_row_f32(x1 + (size_t)t * DM, p.in[33], p.out + (size_t)t * DM, lane);
}

DEV void fast_barrier(unsigned* cnt, unsigned target) {
    asm volatile("s_waitcnt vmcnt(0)" ::: "memory");
    __syncthreads();
    if (threadIdx.x == 0) {
        __builtin_amdgcn_fence(__ATOMIC_RELEASE, "agent");
        asm volatile("s_waitcnt vmcnt(0)" ::: "memory");
        __hip_atomic_fetch_add(cnt, 1u, __ATOMIC_RELAXED, __HIP_MEMORY_SCOPE_AGENT);
        while (__hip_atomic_load(cnt, __ATOMIC_RELAXED, __HIP_MEMORY_SCOPE_AGENT) < target) __builtin_amdgcn_s_sleep(1);
        __builtin_amdgcn_fence(__ATOMIC_ACQUIRE, "agent");
        asm volatile("s_waitcnt vmcnt(0)" ::: "memory");
    }
    __syncthreads();
}

__global__ void __launch_bounds__(512) mega(Params p) {
    extern __shared__ __attribute__((aligned(16))) unsigned char lds_all[];
    unsigned char* lds = lds_all + (threadIdx.x >> 8) * 65536;
    cg::grid_group grid = cg::this_grid();
#define PH(n) if (p.ph_lo <= (n) && (n) < p.ph_hi)
#define GS(n) if (p.ph_lo <= (n) && (n) + 1 < p.ph_hi) { if ((n) == 0) grid.sync(); else fast_barrier((unsigned*)p.ws, (unsigned)(n) * gridDim.x); }
    PH(0) { phase0(p, lds); if (REP_MISC) { __syncthreads(); phase0(p, lds); } }
    GS(0)
    PH(1) { phase1(p, lds_all); if (REP_GEMM) phase1(p, lds_all); }
    GS(1)
    PH(2) phase2(p, lds);
    GS(2)
    PH(3) phase_l2(p, lds);
    GS(3)
    PH(4) { if (!SKIP_SCAN) phase4(p, lds); }
    GS(4)
    PH(5) { phase5(p, lds_all); if (REP_GEMM) phase5(p, lds_all); }
    GS(5)
    PH(6) { phase6(p, lds_all); if (REP_GEMM) phase6(p, lds_all); }
    GS(6)
    PH(7) { phase_norm(p, p.in[26], true); if (REP_MISC) phase_norm(p, p.in[26], true); }
    GS(7)
    PH(8) { phase8(p, lds_all); if (REP_GEMM) phase8(p, lds_all); }
    GS(8)
    PH(9) phase9(p, lds_all);
    GS(9)
    PH(10) { }
    GS(10)
    PH(11) phase11(p, lds_all);
    GS(11)
    PH(12) { phase12(p); if (REP_MISC) phase12(p); }
}

extern "C" void kernel_launch(void* const* d_in, const int* in_sizes, int n_in, void* d_out, int out_size, void* d_ws, size_t ws_size, hipStream_t stream) {
    static int grid_blocks = 0;
    if (!grid_blocks) {
        int dev = 0, cus = 0, per_cu = 0;
        hipGetDevice(&dev);
        hipDeviceGetAttribute(&cus, hipDeviceAttributeMultiprocessorCount, dev);
        hipFuncSetAttribute((const void*)mega, hipFuncAttributeMaxDynamicSharedMemorySize, LDS_BYTES);
        hipOccupancyMaxActiveBlocksPerMultiprocessor(&per_cu, (const void*)mega, 512, LDS_BYTES);
        if (per_cu < 1) per_cu = 1;
        if (per_cu > 1) per_cu = 1;
        grid_blocks = cus * per_cu;
        if (n_in != 34 || ws_size < WS_END1 || ws_size < WS_END2) fprintf(stderr, "kernel_launch: unexpected n_in %d / ws %zu\n", n_in, ws_size);
    }
    hipMemsetAsync(d_ws, 0, 256, stream);
    Params p{};
    for (int i = 0; i < 34; ++i) p.in[i] = (const float*)d_in[i];
    p.out = (float*)d_out;
    p.ws = (unsigned char*)d_ws;
#if MK_MULTI
    for (int ph = 0; ph < NPH; ++ph) {
        p.ph_lo = ph; p.ph_hi = ph + 1;
        hipLaunchKernelGGL(mega, dim3(grid_blocks), dim3(512), LDS_BYTES, stream, p);
    }
#else
    p.ph_lo = 0; p.ph_hi = NPH;
    void* args[] = {&p};
    hipError_t e = hipLaunchCooperativeKernel((const void*)mega, dim3(grid_blocks), dim3(512), args, LDS_BYTES, stream);
    if (e != hipSuccess) fprintf(stderr, "cooperative launch failed: %s (grid %d)\n", hipGetErrorString(e), grid_blocks);
#endif
}
```

```cpp
#include <hip/hip_runtime.h>
#include <hip/hip_cooperative_groups.h>
#include <cstdio>
#include <cstdint>
namespace cg = cooperative_groups;

#ifndef SKIP_SCAN
#define SKIP_SCAN 0
#endif
#ifndef SKIP_NA
#define SKIP_NA 0
#endif
#ifndef REP_SCAN
#define REP_SCAN 0
#endif
#ifndef REP_MISC
#define REP_MISC 0
#endif
#ifndef REP_NA
#define REP_NA 0
#endif
#ifndef REP_SYNC
#define REP_SYNC 0
#endif
#ifndef KSTAGGER
#define KSTAGGER 1
#endif
#ifndef REP_GEMM
#define REP_GEMM 0
#endif
#ifndef MK_MULTI
#define MK_MULTI 0
#endif

#define DEV __device__ __forceinline__
#define VT ((int)(threadIdx.x & 255))
#define VB ((int)(blockIdx.x * 2 + (threadIdx.x >> 8)))
#define VG ((int)(gridDim.x * 2))

typedef unsigned short bf16_t;
typedef short bf16x8 __attribute__((ext_vector_type(8)));
typedef short bf16x4 __attribute__((ext_vector_type(4)));
typedef float f32x4 __attribute__((ext_vector_type(4)));
typedef float f32x2 __attribute__((ext_vector_type(2)));
typedef unsigned u32x4 __attribute__((ext_vector_type(4)));
typedef unsigned u32x2 __attribute__((ext_vector_type(2)));

constexpr int NT = 49152, NTP = 16384, DM = 1024, ZW = 3456, DFF = 2816;
constexpr int CH = 256, NCHUNK = NT / CH, NSUB = CH / 16;
constexpr int NPH = 13;

constexpr size_t OFF_WIN_T = 4096;
constexpr size_t OFF_WBRA_T = OFF_WIN_T + (size_t)5504 * 1024 * 2;
constexpr size_t OFF_WBRN_T = OFF_WBRA_T + (size_t)1024 * 512 * 2;
constexpr size_t OFF_WOUT_T = OFF_WBRN_T + (size_t)1024 * 512 * 2;
constexpr size_t OFF_WGATE_T = OFF_WOUT_T + (size_t)1024 * 1024 * 2;
constexpr size_t OFF_WUP_T = OFF_WGATE_T + (size_t)2816 * 1024 * 2;
constexpr size_t OFF_WDOWN_T = OFF_WUP_T + (size_t)2816 * 1024 * 2;
constexpr size_t OFF_WPLE_T = OFF_WDOWN_T + (size_t)2816 * 1024 * 2;
constexpr size_t OFF_WPG_T = OFF_WPLE_T + (size_t)1024 * 256 * 2;
constexpr size_t OFF_HMIX = OFF_WPG_T + (size_t)1024 * 1024 * 2;
constexpr size_t OFF_Z = OFF_HMIX + (size_t)NT * 1024 * 2;
constexpr size_t OFF_UA = OFF_Z + (size_t)NT * ZW * 2;
constexpr size_t OFF_LORA = OFF_UA + (size_t)NT * 512 * 2;
constexpr size_t WS_END1 = OFF_LORA + 196608 * 2;
constexpr size_t OFF_RSS = WS_END1;
constexpr size_t WS_END3 = OFF_RSS + (size_t)2 * NT * 4 * 4;
constexpr size_t OFF_X1 = OFF_HMIX;
constexpr size_t OFF_ACT = OFF_X1 + (size_t)NT * 1024 * 4;
constexpr size_t WS_END2 = OFF_ACT + (size_t)NT * DFF * 2;
static_assert(WS_END1 <= 536870912ull && WS_END2 <= 536870912ull && WS_END3 <= 536870912ull, "workspace");
constexpr size_t OUT_PBF = (size_t)NT * 1024 * 2;

constexpr int LDS_BYTES = 131072;

struct Params {
    const float* in[34];
    float* out;
    unsigned char* ws;
    int ph_lo, ph_hi;
};

typedef __bf16 bf16x2n __attribute__((ext_vector_type(2)));
DEV unsigned pk2(float lo, float hi) { const f32x2 v = {lo, hi}; return __builtin_bit_cast(unsigned, __builtin_convertvector(v, bf16x2n)); }
DEV float bf_lo(unsigned u) { return __uint_as_float(u << 16); }
DEV float bf_hi(unsigned u) { return __uint_as_float(u & 0xffff0000u); }
DEV f32x4 ld4bf(const bf16_t* p) { u32x2 u = *(const u32x2*)p; return (f32x4){bf_lo(u.x), bf_hi(u.x), bf_lo(u.y), bf_hi(u.y)}; }
DEV void st4bf(bf16_t* p, f32x4 v) { u32x2 u; u.x = pk2(v[0], v[1]); u.y = pk2(v[2], v[3]); *(u32x2*)p = u; }
DEV float wave_sum(float v) {
#pragma unroll
    for (int o = 32; o > 0; o >>= 1) v += __shfl_xor(v, o);
    return v;
}
DEV float dpp_x1(float v) { return __int_as_float(__builtin_amdgcn_update_dpp(0, __float_as_int(v), 0xB1, 0xF, 0xF, true)); }
DEV float dpp_x2(float v) { return __int_as_float(__builtin_amdgcn_update_dpp(0, __float_as_int(v), 0x4E, 0xF, 0xF, true)); }
DEV float dpp_hm(float v) { return __int_as_float(__builtin_amdgcn_update_dpp(0, __float_as_int(v), 0x141, 0xF, 0xF, true)); }
DEV float dpp_rm(float v) { return __int_as_float(__builtin_amdgcn_update_dpp(0, __float_as_int(v), 0x140, 0xF, 0xF, true)); }
DEV float sum16(float v) { v += dpp_x1(v); v += dpp_x2(v); v += dpp_hm(v); v += dpp_rm(v); return v; }
DEV float sigmoidf_(float x) { return __builtin_amdgcn_rcpf(1.f + __expf(-x)); }
DEV const float* xrow(const Params& p, int t) { return t < NTP ? p.in[0] + (size_t)t * DM : p.in[1] + (size_t)(t - NTP) * DM; }
DEV const float* prow(const Params& p, int t) { return t < NTP ? p.in[2] + (size_t)t * 256 : p.in[3] + (size_t)(t - NTP) * 256; }

template <int rmode = 0>
DEV void transpose_tile(const float* __restrict__ W, int K, int N, bf16_t* __restrict__ Wt, int tile, float* lds) {
    const int ntn = N / 64, kb = tile / ntn, nb = tile % ntn, k0 = kb * 64, n0 = nb * 64, tid = VT;
#pragma unroll
    for (int i = 0; i < 16; ++i) { const int kk = (tid >> 6) + 4 * i; lds[kk * 65 + (tid & 63)] = W[(size_t)(k0 + kk) * N + n0 + (tid & 63)]; }
    __syncthreads();
    const int n = tid >> 2, kq = tid & 3;
    unsigned w[8];
#pragma unroll
    for (int j = 0; j < 8; ++j) w[j] = pk2(lds[(kq * 16 + 2 * j) * 65 + n], lds[(kq * 16 + 2 * j + 1) * 65 + n]);
    const int nsrc = n0 + n, nrow = rmode == 0 ? nsrc : ((nsrc >> 4) * 32 + (nsrc & 15) + (rmode == 2 ? 16 : 0));
    u32x4* dst = (u32x4*)(Wt + (size_t)nrow * K + k0 + kq * 16);
    dst[0] = (u32x4){w[0], w[1], w[2], w[3]};
    dst[1] = (u32x4){w[4], w[5], w[6], w[7]};
    __syncthreads();
}

DEV void norm_row_bf16(const float* __restrict__ src, const float* __restrict__ g, bf16_t* __restrict__ dst, int lane) {
    f32x4 v[4]; float s = 0.f;
#pragma unroll
    for (int j = 0; j < 4; ++j) { v[j] = *(const f32x4*)(src + j * 256 + lane * 4); s += v[j][0] * v[j][0] + v[j][1] * v[j][1] + v[j][2] * v[j][2] + v[j][3] * v[j][3]; }
    s = wave_sum(s);
    const float r = 1.0f / sqrtf(s * (1.f / 1024.f) + 1e-6f);
#pragma unroll
    for (int j = 0; j < 4; ++j) { const f32x4 gg = *(const f32x4*)(g + j * 256 + lane * 4); st4bf(dst + j * 256 + lane * 4, v[j] * r * gg); }
}
DEV void norm_row_f32(const float* __restrict__ src, const float* __restrict__ g, float* __restrict__ dst, int lane) {
    f32x4 v[4]; float s = 0.f;
#pragma unroll
    for (int j = 0; j < 4; ++j) { v[j] = *(const f32x4*)(src + j * 256 + lane * 4); s += v[j][0] * v[j][0] + v[j][1] * v[j][1] + v[j][2] * v[j][2] + v[j][3] * v[j][3]; }
    s = wave_sum(s);
    const float r = 1.0f / sqrtf(s * (1.f / 1024.f) + 1e-6f);
#pragma unroll
    for (int j = 0; j < 4; ++j) { const f32x4 gg = *(const f32x4*)(g + j * 256 + lane * 4); *(f32x4*)(dst + j * 256 + lane * 4) = v[j] * r * gg; }
}

DEV void phase0(const Params& p, unsigned char* ldsb) {
    float* lds = (float*)ldsb;
    constexpr int T0 = 16 * 86, T1 = 8 * 16, T2 = 8 * 16, T3 = 16 * 16, T4 = 16 * 44, T5 = 16 * 44, T6 = 44 * 16, T7 = 4 * 16, T8 = 16 * 16;
    constexpr int NTILES = T0 + T1 + T2 + T3 + T4 + T5 + T6 + T7 + T8 + 48;
    for (int it = VB; it < NTILES; it += VG) {
        int r = it;
        if (r < T0) { transpose_tile(p.in[5], 1024, 5504, (bf16_t*)(p.ws + OFF_WIN_T), r, lds); continue; } r -= T0;
        if (r < T1) { transpose_tile(p.in[23], 512, 1024, (bf16_t*)(p.ws + OFF_WBRA_T), r, lds); continue; } r -= T1;
        if (r < T2) { transpose_tile(p.in[24], 512, 1024, (bf16_t*)(p.ws + OFF_WBRN_T), r, lds); continue; } r -= T2;
        if (r < T3) { transpose_tile(p.in[25], 1024, 1024, (bf16_t*)(p.ws + OFF_WOUT_T), r, lds); continue; } r -= T3;
        if (r < T4) { transpose_tile<1>(p.in[27], 1024, 2816, (bf16_t*)(p.ws + OFF_WGATE_T), r, lds); continue; } r -= T4;
        if (r < T5) { transpose_tile<2>(p.in[28], 1024, 2816, (bf16_t*)(p.ws + OFF_WGATE_T), r, lds); continue; } r -= T5;
        if (r < T6) { transpose_tile(p.in[29], 2816, 1024, (bf16_t*)(p.ws + OFF_WDOWN_T), r, lds); continue; } r -= T6;
        if (r < T7) { transpose_tile(p.in[31], 256, 1024, (bf16_t*)(p.ws + OFF_WPLE_T), r, lds); continue; } r -= T7;
        if (r < T8) { transpose_tile(p.in[32], 1024, 1024, (bf16_t*)(p.ws + OFF_WPG_T), r, lds); continue; } r -= T8;
        bf16_t* lb = (bf16_t*)(p.ws + OFF_LORA);
        if (r < 8) { transpose_tile(p.in[9], 64, 512, lb, r, lds); continue; } r -= 8;
        if (r < 8) { transpose_tile(p.in[11], 64, 512, lb + 32768, r, lds); continue; } r -= 8;
        if (r < 8) { transpose_tile(p.in[13], 64, 512, lb + 65536, r, lds); continue; } r -= 8;
        if (r < 8) { transpose_tile(p.in[15], 64, 512, lb + 98304, r, lds); continue; } r -= 8;
        transpose_tile(p.in[16], 128, 512, lb + 131072, r, lds);
    }
    const int wave = VT >> 6, lane = VT & 63;
    bf16_t* hmix = (bf16_t*)(p.ws + OFF_HMIX);
    for (int t = VB * 4 + wave; t < NT; t += VG * 4) norm_row_bf16(xrow(p, t), p.in[4], hmix + (size_t)t * DM, lane);
}

DEV void gemm_acc(f32x4 (&acc)[4][4], const bf16_t* __restrict__ A, int lda, const bf16_t* __restrict__ Bt, int ldb, int K, unsigned char* lds) {
    const int tid = VT, wid = tid >> 6, lane = tid & 63, wr = wid >> 1, wc = wid & 1, fr = lane & 15, fq = lane >> 4;
    const int lr = tid >> 3, lc = tid & 7;
    const bf16_t* ga = A + (size_t)lr * lda + lc * 8;
    const bf16_t* gb = Bt + (size_t)lr * ldb + lc * 8;
    const size_t sa32 = (size_t)32 * lda, sb32 = (size_t)32 * ldb;
    const int soff = lr * 128 + ((lc ^ (lr & 7)) << 4);
    u32x4 ra[4], rb[4];
    const int nk = K >> 6;
#pragma unroll
    for (int i = 0; i < 4; ++i) { ra[i] = *(const u32x4*)(ga + i * sa32); rb[i] = *(const u32x4*)(gb + i * sb32); }
#pragma unroll
    for (int i = 0; i < 4; ++i) { *(u32x4*)(lds + soff + i * 4096) = ra[i]; *(u32x4*)(lds + 16384 + soff + i * 4096) = rb[i]; }
    __syncthreads();
#pragma unroll 1
    for (int kt = 0; kt < nk; ++kt) {
        const bool more = (kt + 1) < nk;
        if (more) {
#pragma unroll
            for (int i = 0; i < 4; ++i) { ra[i] = *(const u32x4*)(ga + i * sa32 + (kt + 1) * 64); rb[i] = *(const u32x4*)(gb + i * sb32 + (kt + 1) * 64); }
        }
        const unsigned char* sa = lds + (kt & 1) * 32768;
        const unsigned char* sb = sa + 16384;
#pragma unroll
        for (int ks = 0; ks < 2; ++ks) {
            bf16x8 af[4], bfr[4];
            const int ch = ((ks * 4 + fq) ^ (fr & 7)) << 4;
#pragma unroll
            for (int m = 0; m < 4; ++m) af[m] = *(const bf16x8*)(sa + (wr * 64 + m * 16 + fr) * 128 + ch);
#pragma unroll
            for (int n = 0; n < 4; ++n) bfr[n] = *(const bf16x8*)(sb + (wc * 64 + n * 16 + fr) * 128 + ch);
#pragma unroll
            for (int m = 0; m < 4; ++m)
#pragma unroll
                for (int n = 0; n < 4; ++n) acc[m][n] = __builtin_amdgcn_mfma_f32_16x16x32_bf16(bfr[n], af[m], acc[m][n], 0, 0, 0);
        }
        if (more) {
            unsigned char* d = lds + ((kt + 1) & 1) * 32768;
#pragma unroll
            for (int i = 0; i < 4; ++i) { *(u32x4*)(d + soff + i * 4096) = ra[i]; *(u32x4*)(d + 16384 + soff + i * 4096) = rb[i]; }
        }
        __syncthreads();
    }
}
DEV void zero_acc(f32x4 (&acc)[4][4]) {
#pragma unroll
    for (int m = 0; m < 4; ++m)
#pragma unroll
        for (int n = 0; n < 4; ++n) acc[m][n] = (f32x4){0.f, 0.f, 0.f, 0.f};
}

struct TileIter {
    int ntn, per_xcd, i, step, x, rows_x;
    DEV void init(int ntm, int ntn_) {
        ntn = ntn_;
        if ((gridDim.x & 7) == 0 && (ntm & 63) == 0) { x = blockIdx.x & 7; i = (int)(blockIdx.x >> 3) * 2 + (int)(threadIdx.x >> 8); step = (int)(gridDim.x >> 3) * 2; rows_x = ntm >> 3; per_xcd = rows_x * ntn; }
        else { x = -1; i = VB; step = VG; rows_x = ntm; per_xcd = ntm * ntn; }
    }
    DEV bool next(int& tm, int& tn) {
        if (i >= per_xcd) return false;
        if (x >= 0) { const int g = i / (8 * ntn), rem = i - g * 8 * ntn; tn = rem >> 3; tm = x * rows_x + g * 8 + (rem & 7); }
        else { tm = i / ntn; tn = i - tm * ntn; }
        i += step; return true;
    }
};

DEV void gemm256_acc(f32x4 (&acc)[8][4], const bf16_t* __restrict__ A, int lda, const bf16_t* __restrict__ Bt, int ldb, int K, unsigned char* lds) {
    __builtin_amdgcn_sched_barrier(0);
    const int tid = threadIdx.x, wid = tid >> 6, lane = tid & 63, wr = wid >> 2, wc = wid & 3, fr = lane & 15, fq = lane >> 4;
    int ozg; asm volatile("s_mov_b32 %0, 0" : "=s"(ozg));
    const int drow = (lane >> 3) + ozg, dch = (lane & 7) ^ (lane >> 3);
    const bf16_t* ga = A + (size_t)(wid * 32 + drow) * lda + dch * 8;
    const bf16_t* gb = Bt + (size_t)(wid * 32 + drow) * ldb + dch * 8;
    const size_t a8 = (size_t)8 * lda, b8 = (size_t)8 * ldb;
    const int nk = K >> 6;
    int kbase = (int)(KSTAGGER == 1 ? (blockIdx.x & 7) * nk / 8 : (KSTAGGER == 2 ? ((blockIdx.x >> 6) & 3) * nk / 4 : 0));
    asm volatile("s_waitcnt vmcnt(0)" ::: "memory");
#define G256_STAGE(kt_) do { unsigned char* sd_ = lds + ((kt_) & 1) * 65536 + wid * 4096; int kk_ = (kt_) + kbase; if (kk_ >= nk) kk_ -= nk; const int ko_ = kk_ * 64; \
        _Pragma("unroll") for (int i_ = 0; i_ < 4; ++i_) { \
            __builtin_amdgcn_global_load_lds((const unsigned*)(ga + i_ * a8 + ko_), (unsigned*)(sd_ + i_ * 1024), 16, 0, 0); \
            __builtin_amdgcn_global_load_lds((const unsigned*)(gb + i_ * b8 + ko_), (unsigned*)(sd_ + 32768 + i_ * 1024), 16, 0, 0); } } while (0)
    const int ch0 = (fq ^ (fr & 7)) << 4, ch1 = ((4 + fq) ^ (fr & 7)) << 4;
    const int aoff = (wr * 128 + fr) * 128, boff = 32768 + (wc * 64 + fr) * 128;
    bf16x8 bf0[4], bf1[4], afA[4], afB[4];
#define LD_B(dst, ch) _Pragma("unroll") for (int n = 0; n < 4; ++n) dst[n] = *(const bf16x8*)(sb + n * 2048 + (ch))
#define LD_A(dst, mh, ch) _Pragma("unroll") for (int m = 0; m < 4; ++m) dst[m] = *(const bf16x8*)(sa + ((mh) * 4 + m) * 2048 + (ch))
#define MM(af, bf, mh) _Pragma("unroll") for (int m = 0; m < 4; ++m) _Pragma("unroll") for (int n = 0; n < 4; ++n) \
            acc[(mh) * 4 + m][n] = __builtin_amdgcn_mfma_f32_16x16x32_bf16(bf[n], af[m], acc[(mh) * 4 + m][n], 0, 0, 0)
#define SB_ __builtin_amdgcn_sched_barrier(0)
    G256_STAGE(0);
    asm volatile("s_waitcnt vmcnt(0)" ::: "memory");
    __builtin_amdgcn_s_barrier();
    if (nk > 1) G256_STAGE(1);
    {
        const unsigned char* sa = lds + aoff; const unsigned char* sb = lds + boff;
        LD_B(bf0, ch0); LD_A(afA, 0, ch0); SB_;
    }
#pragma unroll 1
    for (int kt = 0; kt < nk; ++kt) {
        const unsigned char* sa = lds + (kt & 1) * 65536 + aoff;
        const unsigned char* sb = lds + (kt & 1) * 65536 + boff;
        LD_A(afB, 1, ch0); SB_;
        MM(afA, bf0, 0); SB_;
        LD_B(bf1, ch1); LD_A(afA, 0, ch1); SB_;
        MM(afB, bf0, 1); SB_;
        LD_A(afB, 1, ch1); SB_;
        MM(afA, bf1, 0); SB_;
        asm volatile("s_waitcnt lgkmcnt(0)" ::: "memory");
        asm volatile("s_waitcnt vmcnt(0)" ::: "memory");
        __builtin_amdgcn_s_barrier();
        SB_;
        if (kt + 2 < nk) G256_STAGE(kt + 2);
        if (kt + 1 < nk) {
            const unsigned char* sa = lds + ((kt + 1) & 1) * 65536 + aoff;
            const unsigned char* sb = lds + ((kt + 1) & 1) * 65536 + boff;
            LD_B(bf0, ch0); LD_A(afA, 0, ch0);
        }
        SB_;
        MM(afB, bf1, 1); SB_;
    }
#undef SB_
#undef LD_B
#undef LD_A
#undef MM
#undef G256_STAGE
}
DEV void zero_acc256(f32x4 (&acc)[8][4]) {
#pragma unroll
    for (int m = 0; m < 8; ++m)
#pragma unroll
        for (int n = 0; n < 4; ++n) acc[m][n] = (f32x4){0.f, 0.f, 0.f, 0.f};
}
struct TileIter256 {
    int ntn, per_xcd, i, step, x, rows_x;
    DEV void init(int ntm, int ntn_) {
        ntn = ntn_;
        if ((gridDim.x & 7) == 0 && (ntm & 63) == 0) { x = blockIdx.x & 7; i = blockIdx.x >> 3; step = gridDim.x >> 3; rows_x = ntm >> 3; per_xcd = rows_x * ntn; }
        else { x = -1; i = blockIdx.x; step = gridDim.x; rows_x = ntm; per_xcd = ntm * ntn; }
    }
    DEV bool next(int& tm, int& tn) {
        if (i >= per_xcd) return false;
        if (x >= 0) { const int g = i / (8 * ntn), rem = i - g * 8 * ntn; tn = rem >> 3; tm = x * rows_x + g * 8 + (rem & 7); }
        else { tm = i / ntn; tn = i - tm * ntn; }
        i += step; return true;
    }
};
#define EPI256_COORDS const int tid_ = threadIdx.x, wid_ = tid_ >> 6, lane_ = tid_ & 63, wr_ = wid_ >> 2, wc_ = wid_ & 3, fr_ = lane_ & 15, fq_ = lane_ >> 4;
#define EPI256_ROW(m) (row0 + wr_ * 128 + (m) * 16 + fr_)
#define EPI256_COL(n) (col0 + wc_ * 64 + (n) * 16 + fq_ * 4)

#define EPI_COORDS const int tid_ = VT, wid_ = tid_ >> 6, lane_ = tid_ & 63, wr_ = wid_ >> 1, wc_ = wid_ & 1, fr_ = lane_ & 15, fq_ = lane_ >> 4;
#define EPI_ROW(m) (row0 + wr_ * 64 + (m) * 16 + fr_)
#define EPI_COL(n) (col0 + wc_ * 64 + (n) * 16 + fq_ * 4)

DEV void phase1(const Params& p, unsigned char* lds_all) {
    const bf16_t* hmix = (const bf16_t*)(p.ws + OFF_HMIX);
    const bf16_t* wt = (const bf16_t*)(p.ws + OFF_WIN_T);
    bf16_t* z = (bf16_t*)(p.ws + OFF_Z);
    constexpr int NTN = (ZW + 255) / 256;
    TileIter256 ti; ti.init(NT / 256, NTN);
    for (int tm_, tn_; ti.next(tm_, tn_);) {
        const int row0 = tm_ * 256, col0 = tn_ * 256;
        f32x4 acc[8][4]; zero_acc256(acc);
        gemm256_acc(acc, hmix + (size_t)row0 * DM, DM, wt + (size_t)col0 * DM, DM, DM, lds_all);
        EPI256_COORDS
        int oz; asm volatile("s_mov_b32 %0, 0" : "=s"(oz));
#pragma unroll
        for (int m = 0; m < 8; ++m)
#pragma unroll
            for (int n = 0; n < 4; ++n) {
                const int rl = wr_ * 128 + m * 16 + fr_ + oz, cl = wc_ * 64 + n * 16 + fq_ * 4;
                u32x2 u; u.x = pk2(acc[m][n][0], acc[m][n][1]); u.y = pk2(acc[m][n][2], acc[m][n][3]);
                *(u32x2*)(lds_all + rl * 512 + (((cl >> 3) ^ (rl & 31)) << 4) + ((cl & 7) << 1)) = u;
            }
        __syncthreads();
#pragma unroll
        for (int k = 0; k < 16; ++k) {
            const int idx = tid_ + 512 * k + oz, rl = idx >> 5, ch = idx & 31;
            const u32x4 v = *(const u32x4*)(lds_all + rl * 512 + ((ch ^ (rl & 31)) << 4));
            const int col = col0 + ch * 8;
            if (col < ZW) *(u32x4*)(z + (size_t)(row0 + rl) * ZW + col) = v;
        }
        __syncthreads();
    }
}

constexpr int L_WD = 0, L_AA = 1024, L_BD = 2048, L_KD = 3072, L_RR = 4096, L_VV = 5120, L_XW = 6144, L_XA = 7168, L_BDOT = 8192  , L_O = 10368, L_LG = 11392;
constexpr int LB_XWB = 49664, LB_XAB = 51968, LB_XGB = 54272;

DEV f32x4 shift4(const bf16_t* __restrict__ z, int t, int col, int sstart, int send, const float* __restrict__ mup, const float* __restrict__ mun) {
    const bf16_t* q = z + (size_t)t * ZW + col;
    const f32x4 c = ld4bf(q);
    f32x4 zp = (f32x4){0.f, 0.f, 0.f, 0.f}, zn = (f32x4){0.f, 0.f, 0.f, 0.f};
    if (t > sstart) zp = ld4bf(q - ZW);
    if (t < send - 1) zn = ld4bf(q + ZW);
    const f32x4 mp = *(const f32x4*)(mup + col), mn = *(const f32x4*)(mun + col);
    return c + mp * (zp - c) + mn * (zn - c);
}

struct Raw3 { u32x2 c, p, n; };
DEV Raw3 shift_load(const bf16_t* __restrict__ z, int t, int col, int sstart, int send) {
    const bf16_t* q = z + (size_t)t * ZW + col;
    Raw3 r; r.c = *(const u32x2*)q; r.p = (u32x2){0u, 0u}; r.n = (u32x2){0u, 0u};
    if (t > sstart) r.p = *(const u32x2*)(q - ZW);
    if (t < send - 1) r.n = *(const u32x2*)(q + ZW);
    return r;
}
DEV f32x4 shift_apply(const Raw3& r, int col, const float* __restrict__ mup, const float* __restrict__ mun) {
    const f32x4 c = (f32x4){bf_lo(r.c.x), bf_hi(r.c.x), bf_lo(r.c.y), bf_hi(r.c.y)};
    const f32x4 zp = (f32x4){bf_lo(r.p.x), bf_hi(r.p.x), bf_lo(r.p.y), bf_hi(r.p.y)};
    const f32x4 zn = (f32x4){bf_lo(r.n.x), bf_hi(r.n.x), bf_lo(r.n.y), bf_hi(r.n.y)};
    const f32x4 mp = *(const f32x4*)(mup + col), mn = *(const f32x4*)(mun + col);
    return c + mp * (zp - c) + mn * (zn - c);
}

struct LoraFrag { bf16x8 w[2], a[2], g[4]; };
template <bool L3, int d>
DEV void lora_load(const Params& p, LoraFrag& lf, int h) {
    const int lane = VT & 63, w = VT >> 6, fr = lane & 15, fq = lane >> 4;
    const int c = h * 64 + w * 16 + fr;
    const bf16_t* base = (const bf16_t*)(p.ws + OFF_LORA);
    const bf16_t* w2t = base + (d ? 32768 : 0) + c * 64 + fq * 8;
    const bf16_t* a2t = base + 65536 + (d ? 32768 : 0) + c * 64 + fq * 8;
#pragma unroll
    for (int ks = 0; ks < 2; ++ks) { lf.w[ks] = *(const bf16x8*)(w2t + ks * 32); lf.a[ks] = *(const bf16x8*)(a2t + ks * 32); }
    if (L3 && d == 1) {
        const bf16_t* g2t = base + 131072 + c * 128 + fq * 8;
#pragma unroll
        for (int ks = 0; ks < 4; ++ks) lf.g[ks] = *(const bf16x8*)(g2t + ks * 32);
    }
}
DEV float tanh_fast(float x) { return 1.f - 2.f * __builtin_amdgcn_rcpf(1.f + __expf(2.f * x)); }

template <bool L3, int d>
DEV void scan_prep(const Params& p, float* lds, const LoraFrag& lf, int ts, int tloc0, int h, int sstart, int send) {
    const bf16_t* z = (const bf16_t*)(p.ws + OFF_Z);
    const float* mup = p.in[6];
    const float* mun = p.in[7];
    const int tid = VT, tt = tid >> 4, q16 = tid & 15, t = ts + tt;
    const int j0 = q16 * 4, c0 = h * 64 + j0;
    bf16_t* xwb = (bf16_t*)((unsigned char*)lds + LB_XWB);
    bf16_t* xab = (bf16_t*)((unsigned char*)lds + LB_XAB);
    bf16_t* xgb = (bf16_t*)((unsigned char*)lds + LB_XGB);
    const f32x4 xw = shift4(z, t, 1536 + d * 64 + j0, sstart, send, mup, mun);
    const f32x4 xa = shift4(z, t, 1664 + d * 64 + j0, sstart, send, mup, mun);
    const Raw3 rr = shift_load(z, t, c0, sstart, send), rk3 = shift_load(z, t, 512 + c0, sstart, send), rv = shift_load(z, t, 1024 + c0, sstart, send);
    st4bf(xwb + tt * 72 + j0, (f32x4){tanh_fast(xw[0]), tanh_fast(xw[1]), tanh_fast(xw[2]), tanh_fast(xw[3])});
    st4bf(xab + tt * 72 + j0, xa);
    if (L3 && d == 1) {
#pragma unroll
        for (int e = 0; e < 2; ++e) {
            const f32x4 xg = shift4(z, t, 1792 + q16 * 8 + e * 4, sstart, send, mup, mun);
            st4bf(xgb + tt * 136 + q16 * 8 + e * 4, (f32x4){sigmoidf_(xg[0]), sigmoidf_(xg[1]), sigmoidf_(xg[2]), sigmoidf_(xg[3])});
        }
    }
    __syncthreads();
    {
        const int lane = tid & 63, w = tid >> 6, fr = lane & 15, fq = lane >> 4;
        f32x4 cw = (f32x4){0.f, 0.f, 0.f, 0.f}, ca = cw;
#pragma unroll
        for (int ks = 0; ks < 2; ++ks) {
            const bf16x8 aw = *(const bf16x8*)(xwb + fr * 72 + ks * 32 + fq * 8);
            const bf16x8 aa = *(const bf16x8*)(xab + fr * 72 + ks * 32 + fq * 8);
            cw = __builtin_amdgcn_mfma_f32_16x16x32_bf16(aw, lf.w[ks], cw, 0, 0, 0);
            ca = __builtin_amdgcn_mfma_f32_16x16x32_bf16(aa, lf.a[ks], ca, 0, 0, 0);
        }
#pragma unroll
        for (int j = 0; j < 4; ++j) { lds[L_XW + (fq * 4 + j) * 64 + w * 16 + fr] = cw[j]; lds[L_XA + (fq * 4 + j) * 64 + w * 16 + fr] = ca[j]; }
        if (L3 && d == 1) {
            f32x4 cg = (f32x4){0.f, 0.f, 0.f, 0.f};
#pragma unroll
            for (int ks = 0; ks < 4; ++ks) {
                const bf16x8 ag = *(const bf16x8*)(xgb + fr * 136 + ks * 32 + fq * 8);
                cg = __builtin_amdgcn_mfma_f32_16x16x32_bf16(ag, lf.g[ks], cg, 0, 0, 0);
            }
#pragma unroll
            for (int j = 0; j < 4; ++j) lds[L_LG + (fq * 4 + j) * 64 + w * 16 + fr] = cg[j];
        }
    }
    __syncthreads();
    const f32x4 r4 = shift_apply(rr, c0, mup, mun), k4 = shift_apply(rk3, 512 + c0, mup, mun), v4 = shift_apply(rv, 1024 + c0, mup, mun);
    const f32x4 lw = *(const f32x4*)(lds + L_XW + tt * 64 + j0), la = *(const f32x4*)(lds + L_XA + tt * 64 + j0);
    const f32x4 w0 = *(const f32x4*)((d ? p.in[10] : p.in[8]) + c0);
    const f32x4 a0 = *(const f32x4*)((d ? p.in[14] : p.in[12]) + c0);
    const f32x4 kkw = *(const f32x4*)(p.in[17] + c0);
    const f32x4 kaw = *(const f32x4*)(p.in[18] + c0);
    f32x4 wd, ar, kk;
    float ss = 0.f;
#pragma unroll
    for (int j = 0; j < 4; ++j) {
        const float x = w0[j] + lw[j];
        const float sp = fmaxf(-x, 0.f) + __logf(1.f + __expf(-fabsf(x)));
        wd[j] = __expf(-__expf(-sp - 0.5f));
        ar[j] = __builtin_amdgcn_rcpf(1.f + __expf(-(a0[j] + la[j])));
        kk[j] = k4[j] * kkw[j];
        ss += kk[j] * kk[j];
    }
    ss = sum16(ss);
    const float inv = 1.f / fmaxf(sqrtf(ss), 1e-12f);
    kk = kk * inv;
    f32x4 kd;
#pragma unroll
    for (int j = 0; j < 4; ++j) kd[j] = k4[j] * (1.f + (ar[j] - 1.f) * kaw[j]);
    *(f32x4*)(lds + L_WD + tt * 64 + j0) = wd;
    *(f32x4*)(lds + L_AA + tt * 64 + j0) = -kk;
    *(f32x4*)(lds + L_BD + tt * 64 + j0) = kk * ar;
    *(f32x4*)(lds + L_KD + tt * 64 + j0) = kd;
    *(f32x4*)(lds + L_RR + tt * 64 + j0) = r4;
    *(f32x4*)(lds + L_VV + tt * 64 + j0) = v4;
    if (L3) {
        const f32x4 rk = *(const f32x4*)(p.in[19] + c0);
        float bd = r4[0] * kd[0] * rk[0] + r4[1] * kd[1] * rk[1] + r4[2] * kd[2] * rk[2] + r4[3] * kd[3] * rk[3];
        bd = sum16(bd);
        if (q16 == 0) lds[L_BDOT + tloc0 + tt] += 0.5f * bd;
    }
    __syncthreads();
}

DEV unsigned prefetch_touch(const bf16_t* z, int ts_next, int h, int d, int sstart, int send) {
    unsigned dummy = 0u;
    const int tid = VT;
    if (tid < 126) {
        const int ti = tid / 7, j = tid - ti * 7;
        int t = ts_next - 1 + ti; t = t < sstart ? sstart : t; t = t > send - 1 ? send - 1 : t;
        const int col = j < 3 ? j * 512 + h * 64 : (j == 3 ? 1536 + d * 64 : (j == 4 ? 1664 + d * 64 : (j == 5 ? 1792 : 1856)));
        const bf16_t* q = z + (size_t)t * ZW + col;
        asm volatile("global_load_dword %0, %1, off" : "=v"(dummy) : "v"(q) : "memory");
    }
    return dummy;
}
DEV void prefetch_retire(unsigned dummy) {
    asm volatile("s_waitcnt vmcnt(0)" ::: "memory");
    asm volatile("" :: "v"(dummy));
}

DEV void seq_bounds(int t0, int& sstart, int& send) {
    if (t0 < NTP) { sstart = 0; send = NTP; }
    else { sstart = NTP + ((t0 - NTP) >> 11) * 2048; send = sstart + 2048; }
}

template <int d>
DEV void l1_body(const Params& p, int item, unsigned char* ldsb) {
    float* lds = (float*)ldsb;
    const int h = item & 7, c = item >> 4, t0 = c * CH;
    int sstart, send; seq_bounds(t0, sstart, send);
    const int tid = VT, rp = tid >> 2, part = tid & 3, cb = part * 16;
    f32x2 Sp[8], Su[8];
    int opq; asm volatile("s_mov_b32 %0, 0" : "=s"(opq));
#pragma unroll
    for (int j = 0; j < 8; ++j) { Sp[j] = (f32x2){(rp + opq == cb + 2 * j) ? 1.f : 0.f, (rp + opq == cb + 2 * j + 1) ? 1.f : 0.f}; Su[j] = (f32x2){0.f, 0.f}; }
    LoraFrag lf; lora_load<false, d>(p, lf, h);
    for (int sci = 0; sci < NSUB; ++sci) {
        const int sc = d ? NSUB - 1 - sci : sci;
        scan_prep<false, d>(p, lds, lf, t0 + sc * 16, sc * 16, h, sstart, send);
        const unsigned pfd = prefetch_touch((const bf16_t*)(p.ws + OFF_Z), t0 + (sci + 1 < NSUB ? (d ? sc - 1 : sc + 1) : sc) * 16, h, d, sstart, send);
        f32x4 an[4]; float vvn;
        {
            const int tf = d ? 15 : 0;
#pragma unroll
            for (int j4 = 0; j4 < 4; ++j4) an[j4] = *(const f32x4*)(lds + L_AA + tf * 64 + cb + j4 * 4);
            vvn = lds[L_VV + tf * 64 + rp];
        }
#pragma unroll 1
        for (int sti = 0; sti < 16; ++sti) {
            const int tl = d ? 15 - sti : sti;
            const int tnx = sti == 15 ? tl : (d ? tl - 1 : tl + 1);
            const float* wp = lds + L_WD + tl * 64 + cb;
            const float* bp = lds + L_BD + tl * 64 + cb;
            const float* kp = lds + L_KD + tl * 64 + cb;
            const float vv = vvn;
            f32x4 ac[4];
#pragma unroll
            for (int j4 = 0; j4 < 4; ++j4) ac[j4] = an[j4];
#pragma unroll
            for (int j4 = 0; j4 < 4; ++j4) an[j4] = *(const f32x4*)(lds + L_AA + tnx * 64 + cb + j4 * 4);
            vvn = lds[L_VV + tnx * 64 + rp];
            f32x2 dp = (f32x2){0.f, 0.f}, du = dp;
#pragma unroll
            for (int j4 = 0; j4 < 4; ++j4) {
                const f32x4 a = ac[j4];
                const f32x2 a0 = (f32x2){a[0], a[1]}, a1 = (f32x2){a[2], a[3]};
                dp += Sp[2 * j4] * a0; du += Su[2 * j4] * a0;
                dp += Sp[2 * j4 + 1] * a1; du += Su[2 * j4 + 1] * a1;
            }
            float sap = dp[0] + dp[1], sau = du[0] + du[1];
            sap += dpp_x1(sap); sau += dpp_x1(sau);
            sap += dpp_x2(sap); sau += dpp_x2(sau);
#pragma unroll
            for (int j4 = 0; j4 < 4; ++j4) {
                const f32x4 w = *(const f32x4*)(wp + j4 * 4), b = *(const f32x4*)(bp + j4 * 4), k = *(const f32x4*)(kp + j4 * 4);
                const f32x2 w0 = (f32x2){w[0], w[1]}, w1 = (f32x2){w[2], w[3]}, b0 = (f32x2){b[0], b[1]}, b1 = (f32x2){b[2], b[3]}, k0 = (f32x2){k[0], k[1]}, k1 = (f32x2){k[2], k[3]};
                Sp[2 * j4] = Sp[2 * j4] * w0 + sap * b0;
                Sp[2 * j4 + 1] = Sp[2 * j4 + 1] * w1 + sap * b1;
                Su[2 * j4] = Su[2 * j4] * w0 + (sau * b0 + vv * k0);
                Su[2 * j4 + 1] = Su[2 * j4 + 1] * w1 + (sau * b1 + vv * k1);
            }
        }
        prefetch_retire(pfd);
        __syncthreads();
    }
    float* Pb = p.out;
    float* Ub = p.out + (size_t)NCHUNK * 16 * 4096;
    const size_t off = ((size_t)((c * 8 + h) * 2 + d)) * 4096 + rp * 64 + cb;
#pragma unroll
    for (int j4 = 0; j4 < 4; ++j4) {
        *(f32x4*)(Pb + off + j4 * 4) = (f32x4){Sp[2 * j4][0], Sp[2 * j4][1], Sp[2 * j4 + 1][0], Sp[2 * j4 + 1][1]};
        *(f32x4*)(Ub + off + j4 * 4) = (f32x4){Su[2 * j4][0], Su[2 * j4][1], Su[2 * j4 + 1][0], Su[2 * j4 + 1][1]};
    }
}
DEV void l1_item(const Params& p, int item, unsigned char* ldsb) { if ((item >> 3) & 1) l1_body<1>(p, item, ldsb); else l1_body<0>(p, item, ldsb); }

DEV void l2_item(const Params& p, int seq, int h, int d, int rb, unsigned char* ldsb) {
    float* srow = (float*)ldsb;
    float* pst = (float*)(ldsb + 2048);
    const float* Pb = p.out;
    float* Ub = p.out + (size_t)NCHUNK * 16 * 4096;
    int cbeg, nc;
    if (seq == 0) { cbeg = 0; nc = NTP / CH; } else { cbeg = NTP / CH + (seq - 1) * (2048 / CH); nc = 2048 / CH; }
    const int tid = VT, row = tid >> 5, cg2 = (tid & 31) * 2, grow = rb * 8 + row;
    const int cstep = d ? -1 : 1, cfirst = d ? cbeg + nc - 1 : cbeg;
    const size_t hd = (size_t)(h * 2 + d) * 4096, cstride = (size_t)16 * 4096;
    float sx = 0.f, sy = 0.f;
    f32x4 pa[4], pb[4];
    f32x2 ucur, unext = (f32x2){0.f, 0.f}, unn = unext;
    {
        const float* src = Pb + (size_t)cfirst * cstride + hd;
#pragma unroll
        for (int i = 0; i < 4; ++i) *(f32x4*)(pst + (tid + 256 * i) * 4) = *(const f32x4*)(src + (tid + 256 * i) * 4);
        ucur = *(const f32x2*)(Ub + (size_t)cfirst * cstride + hd + grow * 64 + cg2);
        if (nc > 1) {
            const size_t b1 = (size_t)(cfirst + cstep) * cstride + hd;
#pragma unroll
            for (int i = 0; i < 4; ++i) pa[i] = *(const f32x4*)(Pb + b1 + (tid + 256 * i) * 4);
            unext = *(const f32x2*)(Ub + b1 + grow * 64 + cg2);
        }
    }
#pragma unroll 1
    for (int ci = 0; ci < nc; ++ci) {
        const int c = cfirst + ci * cstep;
        const size_t base = (size_t)c * cstride + hd;
        if (ci + 2 < nc) {
            const size_t b2 = (size_t)(c + 2 * cstep) * cstride + hd;
#pragma unroll
            for (int i = 0; i < 4; ++i) pb[i] = *(const f32x4*)(Pb + b2 + (tid + 256 * i) * 4);
            unn = *(const f32x2*)(Ub + b2 + grow * 64 + cg2);
        }
        *(f32x2*)(Ub + base + grow * 64 + cg2) = (f32x2){sx, sy};
        *(f32x2*)(srow + row * 64 + cg2) = (f32x2){sx, sy};
        __syncthreads();
        const float* ps = pst + (ci & 1) * 4096 + cg2;
        f32x2 a0 = ucur, a1 = (f32x2){0.f, 0.f}, a2 = a1, a3 = a1;
#pragma unroll 4
        for (int k4 = 0; k4 < 16; ++k4) {
            const f32x4 sv = *(const f32x4*)(srow + row * 64 + k4 * 4);
            a0 += sv[0] * *(const f32x2*)(ps + (k4 * 4 + 0) * 64);
            a1 += sv[1] * *(const f32x2*)(ps + (k4 * 4 + 1) * 64);
            a2 += sv[2] * *(const f32x2*)(ps + (k4 * 4 + 2) * 64);
            a3 += sv[3] * *(const f32x2*)(ps + (k4 * 4 + 3) * 64);
        }
        if (ci + 1 < nc) {
            float* dstp = pst + ((ci + 1) & 1) * 4096;
#pragma unroll
            for (int i = 0; i < 4; ++i) *(f32x4*)(dstp + (tid + 256 * i) * 4) = pa[i];
        }
        __syncthreads();
        sx = (a0[0] + a1[0]) + (a2[0] + a3[0]);
        sy = (a0[1] + a1[1]) + (a2[1] + a3[1]);
        ucur = unext; unext = unn;
#pragma unroll
        for (int i = 0; i < 4; ++i) pa[i] = pb[i];
    }
}

DEV void na_item(const Params& p, int item, unsigned char* ldsb, bool to_ua);
DEV void phase_l2(const Params& p, unsigned char* lds) {
    const int G = VG, b = VB;
    constexpr int N_NA = 768 * 8;
    if (G >= 256) {
        constexpr int N_NA_CHAIN = 1024;
        if (b < 128) {
            if (!SKIP_SCAN) l2_item(p, 0, (b >> 4) & 7, (b >> 3) & 1, b & 7, lds);
            __syncthreads();
            if (!SKIP_NA) for (int it = b; it < N_NA_CHAIN; it += 128) { na_item(p, it, lds, false); __syncthreads(); }
        } else {
            if (!SKIP_SCAN) for (int it = b - 128; it < 2048; it += G - 128) l2_item(p, 1 + (it >> 7), (it >> 4) & 7, (it >> 3) & 1, it & 7, lds);
            __syncthreads();
            if (!SKIP_NA) for (int it = N_NA_CHAIN + b - 128; it < N_NA; it += G - 128) { na_item(p, it, lds, false); __syncthreads(); }
        }
    } else {
        if (!SKIP_SCAN) for (int it = b; it < 2176; it += G) l2_item(p, it >> 7, (it >> 4) & 7, (it >> 3) & 1, it & 7, lds);
        __syncthreads();
        if (!SKIP_NA) for (int it = b; it < N_NA; it += G) { na_item(p, it, lds, false); __syncthreads(); }
    }
}

DEV float reduce8(float v) { v += dpp_x1(v); v += dpp_x2(v); v += dpp_hm(v); return v; }
template <int d>
DEV void l3_pass(const Params& p, float* lds, int h, int c, int t0, int sstart, int send) {
    const int tid = VT, rp = tid >> 3, part = tid & 7, cb = part * 8;
    const float* Sb = p.out + (size_t)NCHUNK * 16 * 4096;
    float* yfg = p.out + (size_t)NT * 512;
    bf16_t* ua = (bf16_t*)(p.ws + OFF_UA);
    LoraFrag lf; lora_load<true, d>(p, lf, h);
    {
        f32x2 S0[4], S1[4];
        {
            const float* src = Sb + ((size_t)((c * 8 + h) * 2 + d)) * 4096 + rp * 64 + cb;
#pragma unroll
            for (int j4 = 0; j4 < 2; ++j4) {
                const f32x4 v = *(const f32x4*)(src + j4 * 4), u = *(const f32x4*)(src + 32 * 64 + j4 * 4);
                S0[2 * j4] = (f32x2){v[0], v[1]}; S0[2 * j4 + 1] = (f32x2){v[2], v[3]};
                S1[2 * j4] = (f32x2){u[0], u[1]}; S1[2 * j4 + 1] = (f32x2){u[2], u[3]};
            }
        }
#pragma unroll 1
        for (int sci = 0; sci < NSUB; ++sci) {
            const int sc = d ? NSUB - 1 - sci : sci;
            scan_prep<true, d>(p, lds, lf, t0 + sc * 16, sc * 16, h, sstart, send);
            const unsigned pfd = prefetch_touch((const bf16_t*)(p.ws + OFF_Z), t0 + (sci + 1 < NSUB ? (d ? sc - 1 : sc + 1) : sc) * 16, h, d, sstart, send);
#pragma unroll 1
            for (int sti = 0; sti < 16; ++sti) {
                const int tl = d ? 15 - sti : sti;
                const float* ap = lds + L_AA + tl * 64 + cb;
                const float* wp = lds + L_WD + tl * 64 + cb;
                const float* bp = lds + L_BD + tl * 64 + cb;
                const float* kp = lds + L_KD + tl * 64 + cb;
                const float* rq = lds + L_RR + tl * 64 + cb;
                f32x2 da0 = (f32x2){0.f, 0.f}, da1 = da0, dy0 = da0, dy1 = da0;
#pragma unroll
                for (int j4 = 0; j4 < 2; ++j4) {
                    const f32x4 a = *(const f32x4*)(ap + j4 * 4);
                    const f32x2 a0 = (f32x2){a[0], a[1]}, a1 = (f32x2){a[2], a[3]};
                    da0 += S0[2 * j4] * a0; da1 += S1[2 * j4] * a0; da0 += S0[2 * j4 + 1] * a1; da1 += S1[2 * j4 + 1] * a1;
                    if (d) {
                        const f32x4 r = *(const f32x4*)(rq + j4 * 4);
                        const f32x2 r0 = (f32x2){r[0], r[1]}, r1 = (f32x2){r[2], r[3]};
                        dy0 += S0[2 * j4] * r0; dy1 += S1[2 * j4] * r0; dy0 += S0[2 * j4 + 1] * r1; dy1 += S1[2 * j4 + 1] * r1;
                    }
                }
                const float sa0 = reduce8(da0[0] + da0[1]), sa1 = reduce8(da1[0] + da1[1]);
                const float vv0 = lds[L_VV + tl * 64 + rp], vv1 = lds[L_VV + tl * 64 + rp + 32];
#pragma unroll
                for (int j4 = 0; j4 < 2; ++j4) {
                    const f32x4 w = *(const f32x4*)(wp + j4 * 4), b = *(const f32x4*)(bp + j4 * 4), k = *(const f32x4*)(kp + j4 * 4);
                    const f32x2 w0 = (f32x2){w[0], w[1]}, w1 = (f32x2){w[2], w[3]}, b0 = (f32x2){b[0], b[1]}, b1 = (f32x2){b[2], b[3]}, k0 = (f32x2){k[0], k[1]}, k1 = (f32x2){k[2], k[3]};
                    const f32x2 s00 = S0[2 * j4] * w0 + (sa0 * b0 + vv0 * k0), s01 = S0[2 * j4 + 1] * w1 + (sa0 * b1 + vv0 * k1);
                    const f32x2 s10 = S1[2 * j4] * w0 + (sa1 * b0 + vv1 * k0), s11 = S1[2 * j4 + 1] * w1 + (sa1 * b1 + vv1 * k1);
                    S0[2 * j4] = s00; S0[2 * j4 + 1] = s01; S1[2 * j4] = s10; S1[2 * j4 + 1] = s11;
                    if (!d) {
                        const f32x4 r = *(const f32x4*)(rq + j4 * 4);
                        const f32x2 r0 = (f32x2){r[0], r[1]}, r1 = (f32x2){r[2], r[3]};
                        dy0 += s00 * r0; dy0 += s01 * r1; dy1 += s10 * r0; dy1 += s11 * r1;
                    }
                }
                const float y0 = reduce8(dy0[0] + dy0[1]), y1 = reduce8(dy1[0] + dy1[1]);
                if (part == 0) {
                    if (d) { lds[L_O + tl * 64 + rp] = y0; lds[L_O + tl * 64 + rp + 32] = y1; }
                    else { float* yq = yfg + (size_t)(t0 + sc * 16 + tl) * 512 + h * 64 + rp; yq[0] = y0; yq[32] = y1; }
                }
            }
            prefetch_retire(pfd);
            __syncthreads();
            if (d == 1) {
                const int tt = tid >> 4, q16 = tid & 15, j0 = q16 * 4, c0 = h * 64 + j0, tloc = sc * 16 + tt;
                const f32x4 ov = *(const f32x4*)(lds + L_O + tt * 64 + j0) + *(const f32x4*)(yfg + (size_t)(t0 + tloc) * 512 + c0);
                const float mean = sum16(ov[0] + ov[1] + ov[2] + ov[3]) * (1.f / 64.f);
                const f32x4 dv = ov - mean;
                const float var = sum16(dv[0] * dv[0] + dv[1] * dv[1] + dv[2] * dv[2] + dv[3] * dv[3]) * (1.f / 64.f);
                const float rstd = 1.0f / sqrtf(var + 64e-5f);
                const f32x4 lw = *(const f32x4*)(p.in[20] + c0), lb = *(const f32x4*)(p.in[21] + c0);
                const float bdot = lds[L_BDOT + tloc];
                const f32x4 v4 = *(const f32x4*)(lds + L_VV + tt * 64 + j0);
                const f32x4 g = *(const f32x4*)(lds + L_LG + tt * 64 + j0);
                const f32x4 res = (dv * rstd * lw + lb + bdot * v4) * g;
                st4bf(ua + (size_t)(t0 + tloc) * 512 + c0, res);
                __syncthreads();
            }
        }
    }
}

DEV void l3_item(const Params& p, int item, unsigned char* ldsb) {
    float* lds = (float*)ldsb;
    const int h = item & 7, c = item >> 3, t0 = c * CH;
    int sstart, send; seq_bounds(t0, sstart, send);
    if (VT < CH) lds[L_BDOT + VT] = 0.f;
    l3_pass<0>(p, lds, h, c, t0, sstart, send);
    l3_pass<1>(p, lds, h, c, t0, sstart, send);
}

DEV void na_item(const Params& p, int item, unsigned char* ldsb, bool to_ua) {
    const int h = item & 7, grow = item >> 3;
    int tok0, rows, r;
    if (grow < 256) { tok0 = 0; rows = 256; r = grow; } else { const int g = grow - 256; tok0 = NTP + (g >> 5) * 2048; rows = 32; r = g & 31; }
    int rs = r - 4; rs = rs < 0 ? 0 : rs; rs = rs > rows - 8 ? rows - 8 : rs;
    bf16_t* z = (bf16_t*)(p.ws + OFF_Z);
    float* rpb_l = (float*)ldsb;
    bf16_t* vt = (bf16_t*)(ldsb + 2048);
    const float* rpb = p.in[22] + h * 465;
    const int tid = VT, w = tid >> 6, lane = tid & 63, fr = lane & 15, fq = lane >> 4;
    for (int i = tid; i < 465; i += 256) rpb_l[i] = rpb[i];
    const int qtok = tok0 + r * 64 + w * 16 + fr;
    bf16x8 qf[2];
#pragma unroll
    for (int ks = 0; ks < 2; ++ks) qf[ks] = *(const bf16x8*)(z + (size_t)qtok * ZW + 1920 + h * 64 + ks * 32 + fq * 8);
    const int kb0 = (w < 2) ? 0 : 1;
    f32x4 sc[8][3];
#pragma unroll
    for (int i = 0; i < 8; ++i)
#pragma unroll
        for (int kb = 0; kb < 3; ++kb) {
            const int ktok = tok0 + (rs + i) * 64 + (kb0 + kb) * 16 + fr;
            f32x4 acc = (f32x4){0.f, 0.f, 0.f, 0.f};
#pragma unroll
            for (int ks = 0; ks < 2; ++ks) {
                const bf16x8 kf = *(const bf16x8*)(z + (size_t)ktok * ZW + 2432 + h * 64 + ks * 32 + fq * 8);
                acc = __builtin_amdgcn_mfma_f32_16x16x32_bf16(kf, qf[ks], acc, 0, 0, 0);
            }
            sc[i][kb] = acc;
        }
    const int kp = tid & 31, dg = tid >> 5;
    __syncthreads();
    u32x4 vr[3][2];
    const bf16_t* vbase = z + (size_t)(tok0 + rs * 64 + 2 * kp) * ZW + 2944 + h * 64 + dg * 8;
#pragma unroll
    for (int i = 0; i < 3; ++i) { vr[i][0] = *(const u32x4*)(vbase + (size_t)i * 64 * ZW); vr[i][1] = *(const u32x4*)(vbase + (size_t)i * 64 * ZW + ZW); }
    const int qc = w * 16 + fr;
    int cs = qc - 8; cs = cs < 0 ? 0 : cs; cs = cs > 48 ? 48 : cs;
    float mx = -1e30f;
#pragma unroll
    for (int i = 0; i < 8; ++i)
#pragma unroll
        for (int kb = 0; kb < 3; ++kb)
#pragma unroll
            for (int j = 0; j < 4; ++j) {
                const int kc = (kb0 + kb) * 16 + fq * 4 + j;
                const bool valid = (kc >= cs) && (kc < cs + 16);
                const int dr = rs + i - r + 7, dc = kc - qc + 15;
                const float s = valid ? sc[i][kb][j] * 0.125f + rpb_l[dr * 31 + (valid ? dc : 0)] : -1e30f;
                sc[i][kb][j] = s;
                mx = fmaxf(mx, s);
            }
    mx = fmaxf(mx, __shfl_xor(mx, 16)); mx = fmaxf(mx, __shfl_xor(mx, 32));
    float sum = 0.f;
#pragma unroll
    for (int i = 0; i < 8; ++i)
#pragma unroll
        for (int kb = 0; kb < 3; ++kb)
#pragma unroll
            for (int j = 0; j < 4; ++j) { const float e = __expf(sc[i][kb][j] - mx); sc[i][kb][j] = e; sum += e; }
    sum += __shfl_xor(sum, 16); sum += __shfl_xor(sum, 32);
    const float inv = 1.f / sum;
    f32x4 oacc[4];
#pragma unroll
    for (int dt = 0; dt < 4; ++dt) oacc[dt] = (f32x4){0.f, 0.f, 0.f, 0.f};
#pragma unroll
    for (int i = 0; i < 8; ++i) {
        unsigned* vts = (unsigned*)(vt + (i & 1) * (64 * 72));
#pragma unroll
        for (int e = 0; e < 4; ++e) {
            const unsigned a = vr[i % 3][0][e], b2 = vr[i % 3][1][e];
            vts[((dg * 8 + 2 * e) * 72 + 2 * kp) >> 1] = (a & 0xffffu) | (b2 << 16);
            vts[((dg * 8 + 2 * e + 1) * 72 + 2 * kp) >> 1] = (a >> 16) | (b2 & 0xffff0000u);
        }
        if (i + 3 < 8) { vr[i % 3][0] = *(const u32x4*)(vbase + (size_t)(i + 3) * 64 * ZW); vr[i % 3][1] = *(const u32x4*)(vbase + (size_t)(i + 3) * 64 * ZW + ZW); }
        __syncthreads();
        const bf16_t* vtr = vt + (i & 1) * (64 * 72);
#pragma unroll
        for (int kb = 0; kb < 3; ++kb) {
            u32x2 pu; pu.x = pk2(sc[i][kb][0], sc[i][kb][1]); pu.y = pk2(sc[i][kb][2], sc[i][kb][3]);
            const bf16x4 pb = __builtin_bit_cast(bf16x4, pu);
#pragma unroll
            for (int dt = 0; dt < 4; ++dt) {
                const bf16x4 a = *(const bf16x4*)(vtr + (dt * 16 + fr) * 72 + (kb0 + kb) * 16 + fq * 4);
                oacc[dt] = __builtin_amdgcn_mfma_f32_16x16x16bf16_1k(a, pb, oacc[dt], 0, 0, 0);
            }
        }
    }
    __syncthreads();
    bf16_t* dstp = to_ua ? (bf16_t*)(p.ws + OFF_UA) + (size_t)qtok * 512 + h * 64 : z + (size_t)qtok * ZW + 1920 + h * 64;
#pragma unroll
    for (int dt = 0; dt < 4; ++dt) st4bf(dstp + dt * 16 + fq * 4, oacc[dt] * inv);
}

DEV void phase2(const Params& p, unsigned char* lds) {
    constexpr int N_L1 = NCHUNK * 16;
    for (int it = VB; it < N_L1; it += VG) {
        if (!SKIP_SCAN) { l1_item(p, it, lds); if (REP_SCAN) { __syncthreads(); l1_item(p, it, lds); } }
        __syncthreads();
    }
}
DEV void phase4(const Params& p, unsigned char* lds) {
    for (int it = VB; it < NCHUNK * 8; it += VG) { l3_item(p, it, lds); __syncthreads(); if (REP_SCAN) { l3_item(p, it, lds); __syncthreads(); } }
}

DEV void tile256_put(unsigned char* lds, int rl, int cl, u32x2 u) { *(u32x2*)(lds + rl * 512 + (((cl >> 3) ^ (rl & 31)) << 4) + ((cl & 7) << 1)) = u; }
DEV void tile256_flush(unsigned char* lds, bf16_t* dst, int ld, int row0, int col0, int oz) {
    __syncthreads();
#pragma unroll
    for (int k = 0; k < 16; ++k) {
        const int idx = (int)threadIdx.x + 512 * k + oz, rl = idx >> 5, ch = idx & 31;
        const u32x4 v = *(const u32x4*)(lds + rl * 512 + ((ch ^ (rl & 31)) << 4));
        *(u32x4*)(dst + (size_t)(row0 + rl) * ld + col0 + ch * 8) = v;
    }
    __syncthreads();
}

template <bool ADD>
DEV void tile256_gate_bf16(unsigned char* lds, const bf16_t* gate, const bf16_t* addend, bf16_t* dst, int ld, const f32x4 (&acc)[8][4], int oz) {
    const int tid = threadIdx.x, wid = tid >> 6, lane = tid & 63, wr = wid >> 2, wc = wid & 3, fr = lane & 15, fq = lane >> 4;
#pragma unroll
    for (int half = 0; half < 2; ++half) {
        asm volatile("s_waitcnt vmcnt(0)" ::: "memory");
#pragma unroll 2
        for (int i = 0; i < 8; ++i) {
            const int r0 = wid * 16 + 2 * i + oz, rl = r0 + (lane >> 5);
            const size_t go = (size_t)(half * 128 + rl) * ld + (((lane & 31) ^ (rl & 31)) << 3);
            __builtin_amdgcn_global_load_lds((const unsigned*)(gate + go), (unsigned*)(lds + r0 * 512), 16, 0, 0);
            if (ADD) __builtin_amdgcn_global_load_lds((const unsigned*)(addend + go), (unsigned*)(lds + 65536 + r0 * 512), 16, 0, 0);
        }
        asm volatile("s_waitcnt vmcnt(0)" ::: "memory");
        __syncthreads();
        if (wr == half) {
#pragma unroll
            for (int m = 0; m < 8; ++m)
#pragma unroll
                for (int n = 0; n < 4; ++n) {
                    const int rl = m * 16 + fr + oz, cl = wc * 64 + n * 16 + fq * 4;
                    unsigned char* q = lds + rl * 512 + (((cl >> 3) ^ (rl & 31)) << 4) + ((cl & 7) << 1);
                    const u32x2 gu = *(const u32x2*)q;
                    f32x4 v = (f32x4){bf_lo(gu.x), bf_hi(gu.x), bf_lo(gu.y), bf_hi(gu.y)} * acc[m][n];
                    if (ADD) { const u32x2 mu = *(const u32x2*)(q + 65536); v += (f32x4){bf_lo(mu.x), bf_hi(mu.x), bf_lo(mu.y), bf_hi(mu.y)}; }
                    u32x2 o; o.x = pk2(v[0], v[1]); o.y = pk2(v[2], v[3]);
                    *(u32x2*)q = o;
                }
        }
        __syncthreads();
#pragma unroll 4
        for (int k = 0; k < 8; ++k) {
            const int idx = tid + 512 * k + oz, rl = idx >> 5, ch = idx & 31;
            const u32x4 v = *(const u32x4*)(lds + rl * 512 + ((ch ^ (rl & 31)) << 4));
            *(u32x4*)(dst + (size_t)(half * 128 + rl) * ld + ch * 8) = v;
        }
        __syncthreads();
    }
}

DEV void phase5(const Params& p, unsigned char* lds_all) {
    const bf16_t* hmix = (const bf16_t*)(p.ws + OFF_HMIX);
    const bf16_t* wt = (const bf16_t*)(p.ws + OFF_WIN_T);
    const bf16_t* wa = (const bf16_t*)(p.ws + OFF_WBRA_T);
    const bf16_t* wn = (const bf16_t*)(p.ws + OFF_WBRN_T);
    const bf16_t* ua = (const bf16_t*)(p.ws + OFF_UA);
    const bf16_t* z = (const bf16_t*)(p.ws + OFF_Z);
    bf16_t* mb = (bf16_t*)p.out;
    bf16_t* tb = (bf16_t*)((unsigned char*)p.out + OUT_PBF);
    TileIter256 ti; ti.init(NT / 256, 4);
    for (int tm_, tn_; ti.next(tm_, tn_);) {
        const int row0 = tm_ * 256, col0 = tn_ * 256;
        EPI256_COORDS
        f32x4 acc[8][4];
        zero_acc256(acc); gemm256_acc(acc, hmix + (size_t)row0 * DM, DM, wt + (size_t)(ZW + col0) * DM, DM, DM, lds_all);
        int oz1; asm volatile("s_mov_b32 %0, 0" : "=s"(oz1));
#pragma unroll
        for (int m = 0; m < 8; ++m)
#pragma unroll
            for (int n = 0; n < 4; ++n) {
                f32x4 v;
#pragma unroll
                for (int j = 0; j < 4; ++j) v[j] = sigmoidf_(acc[m][n][j]);
                u32x2 u; u.x = pk2(v[0], v[1]); u.y = pk2(v[2], v[3]);
                tile256_put(lds_all, wr_ * 128 + m * 16 + fr_ + oz1, wc_ * 64 + n * 16 + fq_ * 4, u);
            }
        tile256_flush(lds_all, mb, DM, row0, col0, oz1);
        zero_acc256(acc); gemm256_acc(acc, ua + (size_t)row0 * 512, 512, wa + (size_t)col0 * 512, 512, 512, lds_all);
        int oz2; asm volatile("s_mov_b32 %0, 0" : "=s"(oz2));
        { bf16_t* mt = mb + (size_t)row0 * DM + col0; tile256_gate_bf16<false>(lds_all, mt, mt, mt, DM, acc, oz2); }
        zero_acc256(acc); gemm256_acc(acc, hmix + (size_t)row0 * DM, DM, wt + (size_t)(ZW + 1024 + col0) * DM, DM, DM, lds_all);
        int oz3; asm volatile("s_mov_b32 %0, 0" : "=s"(oz3));
#pragma unroll
        for (int m = 0; m < 8; ++m)
#pragma unroll
            for (int n = 0; n < 4; ++n) {
                f32x4 v;
#pragma unroll
                for (int j = 0; j < 4; ++j) v[j] = sigmoidf_(acc[m][n][j]);
                u32x2 u; u.x = pk2(v[0], v[1]); u.y = pk2(v[2], v[3]);
                tile256_put(lds_all, wr_ * 128 + m * 16 + fr_ + oz3, wc_ * 64 + n * 16 + fq_ * 4, u);
            }
        tile256_flush(lds_all, tb, DM, row0, col0, oz3);
        zero_acc256(acc); gemm256_acc(acc, z + (size_t)row0 * ZW + 1920, ZW, wn + (size_t)col0 * 512, 512, 512, lds_all);
        int oz4; asm volatile("s_mov_b32 %0, 0" : "=s"(oz4));
        { bf16_t* mt = mb + (size_t)row0 * DM + col0; tile256_gate_bf16<true>(lds_all, tb + (size_t)row0 * DM + col0, mt, mt, DM, acc, oz4); }
    }
}

template <bool NORM = false>
DEV void tile256_resid_f32(unsigned char* lds, const float* src, float* dst, const f32x4 (&acc)[8][4], int oz,
                           bf16_t* hu = nullptr, const float* gain = nullptr, float* rss = nullptr) {
    const int tid = threadIdx.x, wid = tid >> 6, lane = tid & 63, wr = wid >> 2, wc = wid & 3, fr = lane & 15, fq = lane >> 4;
#pragma unroll
    for (int half = 0; half < 2; ++half) {
        asm volatile("s_waitcnt vmcnt(0)" ::: "memory");
#pragma unroll 2
        for (int i = 0; i < 16; ++i) {
            const int rl = wid * 16 + i + oz;
            const float* g = src + (size_t)(half * 128 + rl) * DM + ((lane ^ (rl & 63)) << 2);
            __builtin_amdgcn_global_load_lds((const unsigned*)g, (unsigned*)(lds + rl * 1024), 16, 0, 0);
        }
        asm volatile("s_waitcnt vmcnt(0)" ::: "memory");
        __syncthreads();
        if (wr == half) {
#pragma unroll
            for (int m = 0; m < 8; ++m)
#pragma unroll
                for (int n = 0; n < 4; ++n) {
                    const int rl = m * 16 + fr + oz, ch = (wc * 64 + n * 16 + fq * 4) >> 2;
                    f32x4* q = (f32x4*)(lds + rl * 1024 + ((ch ^ (rl & 63)) << 4));
                    *q = *q + acc[m][n];
                }
        }
        __syncthreads();
        f32x4 g4 = (f32x4){0.f, 0.f, 0.f, 0.f};
        if (NORM) g4 = *(const f32x4*)(gain + lane * 4);
#pragma unroll 4
        for (int k = 0; k < 16; ++k) {
            const int idx = tid + 512 * k + oz, rl = idx >> 6, ch = idx & 63;
            const f32x4 v = *(const f32x4*)(lds + rl * 1024 + ((ch ^ (rl & 63)) << 4));
            *(f32x4*)(dst + (size_t)(half * 128 + rl) * DM + ch * 4) = v;
            if (NORM) {
                st4bf(hu + (size_t)(half * 128 + rl) * DM + ch * 4, v * g4);
                const float ss = wave_sum((v[0] * v[0] + v[1] * v[1]) + (v[2] * v[2] + v[3] * v[3]));
                if (lane == 0) rss[(size_t)(half * 128 + rl) * 4] = ss;
            }
        }
        __syncthreads();
    }
}

DEV void phase6(const Params& p, unsigned char* lds_all) {
    const bf16_t* mb = (const bf16_t*)p.out;
    const bf16_t* wo = (const bf16_t*)(p.ws + OFF_WOUT_T);
    float* x1 = (float*)(p.ws + OFF_X1);
    TileIter256 ti; ti.init(NT / 256, 4);
    for (int tm_, tn_; ti.next(tm_, tn_);) {
        const int row0 = tm_ * 256, col0 = tn_ * 256;
        f32x4 acc[8][4]; zero_acc256(acc);
        gemm256_acc(acc, mb + (size_t)row0 * DM, DM, wo + (size_t)col0 * DM, DM, DM, lds_all);
        int oz; asm volatile("s_mov_b32 %0, 0" : "=s"(oz));
        tile256_resid_f32<true>(lds_all, xrow(p, row0) + col0, x1 + (size_t)row0 * DM + col0, acc, oz,
                                (bf16_t*)((unsigned char*)p.out + OUT_PBF) + (size_t)row0 * DM + col0, p.in[26] + col0,
                                (float*)(p.ws + OFF_RSS) + (size_t)NT * 4 + (size_t)row0 * 4 + tn_);
    }
}

DEV void phase_norm(const Params& p, const float* g, bool with_p) {
    const float* x1 = (const float*)(p.ws + OFF_X1);
    bf16_t* hb = (bf16_t*)p.out;
    const int wave = VT >> 6, lane = VT & 63;
    for (int t = VB * 4 + wave; t < NT; t += VG * 4) {
        norm_row_bf16(x1 + (size_t)t * DM, g, hb + (size_t)t * DM, lane);
        if (with_p) {
            bf16_t* pb = (bf16_t*)((unsigned char*)p.out + OUT_PBF);
            const f32x4 v = *(const f32x4*)(prow(p, t) + lane * 4);
            st4bf(pb + (size_t)t * 256 + lane * 4, v);
        }
    }
}

DEV void phase_pconv(const Params& p) {
    bf16_t* pb = (bf16_t*)p.out;
    const int wave = VT >> 6, lane = VT & 63;
    for (int t = VB * 4 + wave; t < NT; t += VG * 4) {
        const f32x4 v = *(const f32x4*)(prow(p, t) + lane * 4);
        st4bf(pb + (size_t)t * 256 + lane * 4, v);
    }
}

DEV void phase8(const Params& p, unsigned char* lds_all) {
    const bf16_t* h2 = (const bf16_t*)((const unsigned char*)p.out + OUT_PBF);
    const float* rss1 = (const float*)(p.ws + OFF_RSS) + (size_t)NT * 4;
    const bf16_t* wgu = (const bf16_t*)(p.ws + OFF_WGATE_T);
    bf16_t* act = (bf16_t*)(p.ws + OFF_ACT);
    TileIter256 ti; ti.init(NT / 256, 2 * DFF / 256);
    for (int tm_, tn_; ti.next(tm_, tn_);) {
        const int row0 = tm_ * 256, col0 = tn_ * 256;
        f32x4 acc[8][4]; zero_acc256(acc);
        gemm256_acc(acc, h2 + (size_t)row0 * DM, DM, wgu + (size_t)col0 * DM, DM, DM, lds_all);
        EPI256_COORDS
        int oz; asm volatile("s_mov_b32 %0, 0" : "=s"(oz));
#pragma unroll
        for (int m = 0; m < 8; ++m) {
            const f32x4 sq = *(const f32x4*)(rss1 + (size_t)(EPI256_ROW(m) + oz) * 4);
            const float rs = 1.0f / sqrtf(((sq[0] + sq[1]) + (sq[2] + sq[3])) * (1.f / 1024.f) + 1e-6f);
#pragma unroll
            for (int q = 0; q < 2; ++q) {
                f32x4 v;
#pragma unroll
                for (int j = 0; j < 4; ++j) { const float gq = acc[m][2 * q][j] * rs; v[j] = gq * sigmoidf_(gq) * (acc[m][2 * q + 1][j] * rs); }
                const int rl = wr_ * 128 + m * 16 + fr_ + oz, cl = wc_ * 32 + q * 16 + fq_ * 4;
                u32x2 u; u.x = pk2(v[0], v[1]); u.y = pk2(v[2], v[3]);
                *(u32x2*)(lds_all + rl * 256 + (((cl >> 3) ^ (rl & 15)) << 4) + ((cl & 7) << 1)) = u;
            }
        }
        __syncthreads();
#pragma unroll
        for (int k = 0; k < 8; ++k) {
            const int idx = tid_ + 512 * k + oz, rl = idx >> 4, ch = idx & 15;
            const u32x4 v = *(const u32x4*)(lds_all + rl * 256 + ((ch ^ (rl & 15)) << 4));
            *(u32x4*)(act + (size_t)(row0 + rl) * DFF + tn_ * 128 + ch * 8) = v;
        }
        __syncthreads();
    }
}

DEV void phase9(const Params& p, unsigned char* lds_all) {
    const bf16_t* act = (const bf16_t*)(p.ws + OFF_ACT);
    const bf16_t* wd = (const bf16_t*)(p.ws + OFF_WDOWN_T);
    float* x1 = (float*)(p.ws + OFF_X1);
    TileIter256 ti; ti.init(NT / 256, 4);
    for (int tm_, tn_; ti.next(tm_, tn_);) {
        const int row0 = tm_ * 256, col0 = tn_ * 256;
        f32x4 acc[8][4]; zero_acc256(acc);
        gemm256_acc(acc, act + (size_t)row0 * DFF, DFF, wd + (size_t)col0 * DFF, DFF, DFF, lds_all);
        int oz; asm volatile("s_mov_b32 %0, 0" : "=s"(oz));
        float* xt = x1 + (size_t)row0 * DM + col0;
        tile256_resid_f32<true>(lds_all, xt, xt, acc, oz, (bf16_t*)((unsigned char*)p.out + OUT_PBF) + (size_t)row0 * DM + col0, p.in[30] + col0,
                                (float*)(p.ws + OFF_RSS) + (size_t)row0 * 4 + tn_);
    }
}

DEV void phase11(const Params& p, unsigned char* lds_all) {
    const bf16_t* h3 = (const bf16_t*)((const unsigned char*)p.out + OUT_PBF);
    const bf16_t* pb = (const bf16_t*)p.out;
    const bf16_t* wp = (const bf16_t*)(p.ws + OFF_WPLE_T);
    const bf16_t* wg = (const bf16_t*)(p.ws + OFF_WPG_T);
    bf16_t* tb = (bf16_t*)(p.ws + OFF_ACT);
    float* x1 = (float*)(p.ws + OFF_X1);
    TileIter256 ti; ti.init(NT / 256, 4);
    for (int tm_, tn_; ti.next(tm_, tn_);) {
        const int row0 = tm_ * 256, col0 = tn_ * 256;
        EPI256_COORDS
        f32x4 acc[8][4];
        zero_acc256(acc); gemm256_acc(acc, h3 + (size_t)row0 * DM, DM, wg + (size_t)col0 * DM, DM, DM, lds_all);
        int oz1; asm volatile("s_mov_b32 %0, 0" : "=s"(oz1));
#pragma unroll
        for (int m = 0; m < 8; ++m) {
            const f32x4 sq = *(const f32x4*)((const float*)(p.ws + OFF_RSS) + (size_t)(EPI256_ROW(m) + oz1) * 4);
            const float rs = 1.0f / sqrtf(((sq[0] + sq[1]) + (sq[2] + sq[3])) * (1.f / 1024.f) + 1e-6f);
#pragma unroll
            for (int n = 0; n < 4; ++n) {
                f32x4 v;
#pragma unroll
                for (int j = 0; j < 4; ++j) v[j] = sigmoidf_(acc[m][n][j] * rs);
                u32x2 u; u.x = pk2(v[0], v[1]); u.y = pk2(v[2], v[3]);
                tile256_put(lds_all, wr_ * 128 + m * 16 + fr_ + oz1, wc_ * 64 + n * 16 + fq_ * 4, u);
            }
        }
        tile256_flush(lds_all, tb, DM, row0, col0, oz1);
        zero_acc256(acc); gemm256_acc(acc, pb + (size_t)row0 * 256, 256, wp + (size_t)col0 * 256, 256, 256, lds_all);
        int oz2; asm volatile("s_mov_b32 %0, 0" : "=s"(oz2));
        const float* __restrict__ xin = x1; float* __restrict__ xo = x1;
        __builtin_amdgcn_sched_barrier(0);
#pragma unroll
        for (int m = 0; m < 8; ++m) {
            __builtin_amdgcn_sched_barrier(0);
            const size_t ro = (size_t)(EPI256_ROW(m) + oz2) * DM;
            f32x4 t[4], g[4];
#pragma unroll
            for (int n = 0; n < 4; ++n) { t[n] = *(const f32x4*)(xin + ro + EPI256_COL(n)); g[n] = ld4bf(tb + ro + EPI256_COL(n)); }
#pragma unroll
            for (int n = 0; n < 4; ++n) *(f32x4*)(xo + ro + EPI256_COL(n)) = t[n] + acc[m][n] * g[n];
        }
    }
}

DEV void phase12(const Params& p) {
    const float* x1 = (const float*)(p.ws + OFF_X1);
    const int wave = VT >> 6, lane = VT & 63;
    for (int t = VB * 4 + wave; t < NT; t += VG * 4) norm_row_f32(x1 + (size_t)t * DM, p.in[33], p.out + (size_t)t * DM, lane);
}

DEV void fast_barrier(unsigned* cnt, unsigned target) {
    asm volatile("s_waitcnt vmcnt(0)" ::: "memory");
    __syncthreads();
    if (threadIdx.x == 0) {
        __builtin_amdgcn_fence(__ATOMIC_RELEASE, "agent");
        asm volatile("s_waitcnt vmcnt(0)" ::: "memory");
        __hip_atomic_fetch_add(cnt, 1u, __ATOMIC_RELAXED, __HIP_MEMORY_SCOPE_AGENT);
        while (__hip_atomic_load(cnt, __ATOMIC_RELAXED, __HIP_MEMORY_SCOPE_AGENT) < target) __builtin_amdgcn_s_sleep(1);
        __builtin_amdgcn_fence(__ATOMIC_ACQUIRE, "agent");
        asm volatile("s_waitcnt vmcnt(0)" ::: "memory");
    }
    __syncthreads();
}

__global__ void __launch_bounds__(512) mega(Params p) {
    extern __shared__ __attribute__((aligned(16))) unsigned char lds_all[];
    unsigned char* lds = lds_all + (threadIdx.x >> 8) * 65536;
    cg::grid_group grid = cg::this_grid();
#define PH(n) if (p.ph_lo <= (n) && (n) < p.ph_hi)
#define GS(n) if (p.ph_lo <= (n) && (n) + 1 < p.ph_hi) { if ((n) == 0) grid.sync(); else fast_barrier((unsigned*)p.ws, (unsigned)(n) * gridDim.x); }
    PH(0) { phase0(p, lds); if (REP_MISC) { __syncthreads(); phase0(p, lds); } }
    GS(0)
    PH(1) { phase1(p, lds_all); if (REP_GEMM) phase1(p, lds_all); }
    GS(1)
    PH(2) phase2(p, lds);
    GS(2)
    PH(3) phase_l2(p, lds);
    GS(3)
    PH(4) { if (!SKIP_SCAN) phase4(p, lds); }
    GS(4)
    PH(5) { phase5(p, lds_all); if (REP_GEMM) phase5(p, lds_all); }
    GS(5)
    PH(6) { phase6(p, lds_all); if (REP_GEMM) phase6(p, lds_all); }
    GS(6)
    PH(7) phase_pconv(p);
    GS(7)
    PH(8) { phase8(p, lds_all); if (REP_GEMM) phase8(p, lds_all); }
    GS(8)
    PH(9) phase9(p, lds_all);
    GS(9)
    PH(10) { }
    GS(10)
    PH(11) phase11(p, lds_all);
    GS(11)
    PH(12) { phase12(p); if (REP_MISC) phase12(p); }
}

extern "C" void kernel_launch(void* const* d_in, const int* in_sizes, int n_in, void* d_out, int out_size, void* d_ws, size_t ws_size, hipStream_t stream) {
    static int grid_blocks = 0;
    if (!grid_blocks) {
        int dev = 0, cus = 0, per_cu = 0;
        hipGetDevice(&dev);
        hipDeviceGetAttribute(&cus, hipDeviceAttributeMultiprocessorCount, dev);
        hipFuncSetAttribute((const void*)mega, hipFuncAttributeMaxDynamicSharedMemorySize, LDS_BYTES);
        hipOccupancyMaxActiveBlocksPerMultiprocessor(&per_cu, (const void*)mega, 512, LDS_BYTES);
        if (per_cu < 1) per_cu = 1;
        if (per_cu > 1) per_cu = 1;
        grid_blocks = cus * per_cu;
        if (n_in != 34 || ws_size < WS_END1 || ws_size < WS_END2) fprintf(stderr, "kernel_launch: unexpected n_in %d / ws %zu\n", n_in, ws_size);
    }
    hipMemsetAsync(d_ws, 0, 256, stream);
    Params p{};
    for (int i = 0; i < 34; ++i) p.in[i] = (const float*)d_in[i];
    p.out = (float*)d_out;
    p.ws = (unsigned char*)d_ws;
#if MK_MULTI
    for (int ph = 0; ph < NPH; ++ph) {
        p.ph_lo = ph; p.ph_hi = ph + 1;
        hipLaunchKernelGGL(mega, dim3(grid_blocks), dim3(512), LDS_BYTES, stream, p);
    }
#else
    p.ph_lo = 0; p.ph_hi = NPH;
    void* args[] = {&p};
    hipError_t e = hipLaunchCooperativeKernel((const void*)mega, dim3(grid_blocks), dim3(512), args, LDS_BYTES, stream);
    if (e != hipSuccess) fprintf(stderr, "cooperative launch failed: %s (grid %d)\n", hipGetErrorString(e), grid_blocks);
#endif
}
```
